# Optimizing an MI355X kernel written in HIP

```python
import jax, jax.numpy as jnp
from jax import lax
import numpy as np

D_MODEL = 1024
BATCH = 2
SEQ = 16384
DEPTH = 2

MEM_LEN = 256
HEAD_DIM = 64
LRU_WIDTH = 256
LRU_BLOCKS = 4
LRU_BLOCK = LRU_WIDTH // LRU_BLOCKS
CONV_WIDTH = 4
LRU_C = 8.0
FOX_HEADS = 8
FOX_WIDTH = FOX_HEADS * HEAD_DIM
RET_HEADS = 4
RET_WIDTH = RET_HEADS * HEAD_DIM
MIX_WIDTH = LRU_WIDTH + FOX_WIDTH + RET_WIDTH
SPLIT_SIZES = (LRU_WIDTH, LRU_WIDTH, FOX_WIDTH, FOX_WIDTH, FOX_WIDTH, FOX_HEADS, RET_WIDTH, RET_WIDTH, RET_WIDTH, RET_WIDTH)
IN_WIDTH = sum(SPLIT_SIZES)
CROSS_HEADS = 4
CROSS_HEAD_DIM = D_MODEL // CROSS_HEADS
D_FF = ((8 * D_MODEL + 3 * 256 - 1) // (3 * 256)) * 256
Q_BLOCK = 128
RET_CHUNK = 128
ROPE_THETA = 10000.0
EPS = 1e-6

kernel_name = 'hymba_style_lru_fox_retention_hybrid'


def rms_norm(x, g):
    xf = x.astype(jnp.float32)
    y = xf * lax.rsqrt(jnp.mean(xf * xf, axis=-1, keepdims=True) + EPS)
    return (y * g.astype(jnp.float32)).astype(x.dtype)


def causal_depthwise_conv(x, w, b):
    c = x.shape[-1]
    xp = jnp.pad(x, ((0, 0), (CONV_WIDTH - 1, 0), (0, 0)))
    out = lax.conv_general_dilated(xp, w.astype(x.dtype)[:, None, :], window_strides=(1,), padding='VALID', dimension_numbers=('NWC', 'WIO', 'NWC'), feature_group_count=c)
    return out + b.astype(x.dtype)


def rg_lru(x, w_r, b_r, w_i, b_i, lam):
    bsz, s, _ = x.shape
    xb = x.reshape(bsz, s, LRU_BLOCKS, LRU_BLOCK)
    r = jax.nn.sigmoid((jnp.einsum('bsni,nij->bsnj', xb, w_r).reshape(bsz, s, LRU_WIDTH) + b_r).astype(jnp.float32))
    i = jax.nn.sigmoid((jnp.einsum('bsni,nij->bsnj', xb, w_i).reshape(bsz, s, LRU_WIDTH) + b_i).astype(jnp.float32))
    log_a = -LRU_C * r * jax.nn.softplus(-lam.astype(jnp.float32))
    a = jnp.exp(log_a)
    u = jnp.sqrt(-jnp.expm1(2.0 * log_a)) * (i * x.astype(jnp.float32))

    def combine(left, right):
        a1, b1 = left
        a2, b2 = right
        return a1 * a2, a2 * b1 + b2

    _, h = lax.associative_scan(combine, (a, u), axis=1)
    return h.astype(x.dtype)


def forgetting_attention(q, k, v, f_logit, b_f):
    bsz, s, _ = q.shape
    q = q.reshape(bsz, s, FOX_HEADS, HEAD_DIM).transpose(0, 2, 1, 3)
    k = k.reshape(bsz, s, FOX_HEADS, HEAD_DIM).transpose(0, 2, 1, 3)
    v = v.reshape(bsz, s, FOX_HEADS, HEAD_DIM).transpose(0, 2, 1, 3)
    log_f = jax.nn.log_sigmoid((f_logit + b_f).astype(jnp.float32))
    c = jnp.cumsum(log_f, axis=1).transpose(0, 2, 1)
    key_pos = jnp.arange(s)
    scale = HEAD_DIM ** -0.5

    def block(bi):
        start = bi * Q_BLOCK
        qb = lax.dynamic_slice_in_dim(q, start, Q_BLOCK, axis=2)
        cb = lax.dynamic_slice_in_dim(c, start, Q_BLOCK, axis=2)
        logits = jnp.einsum('bhqd,bhkd->bhqk', qb, k).astype(jnp.float32) * scale + cb[..., None] - c[:, :, None, :]
        q_pos = start + jnp.arange(Q_BLOCK)
        mask = key_pos[None, :] <= q_pos[:, None]
        p = jax.nn.softmax(jnp.where(mask, logits, -jnp.inf), axis=-1)
        return jnp.einsum('bhqk,bhkd->bhqd', p.astype(v.dtype), v)

    out = lax.map(block, jnp.arange(s // Q_BLOCK))
    return out.transpose(1, 0, 3, 2, 4).reshape(bsz, s, FOX_WIDTH)


def rotary(x, positions):
    half = x.shape[-1] // 2
    inv_freq = ROPE_THETA ** (-jnp.arange(half, dtype=jnp.float32) / half)
    ang = positions.astype(jnp.float32)[..., None] * inv_freq
    cos = jnp.cos(ang)[:, :, None, :]
    sin = jnp.sin(ang)[:, :, None, :]
    xf = x.astype(jnp.float32)
    x1, x2 = xf[..., :half], xf[..., half:]
    return jnp.concatenate([x1 * cos - x2 * sin, x1 * sin + x2 * cos], axis=-1)


def retention(q, k, v, g, positions):
    bsz, s, _ = q.shape
    n_chunks = s // RET_CHUNK
    shp = (bsz, n_chunks, RET_CHUNK, RET_HEADS, HEAD_DIM)
    qc = rotary(q.reshape(bsz, s, RET_HEADS, HEAD_DIM), positions).reshape(shp)
    kc = (rotary(k.reshape(bsz, s, RET_HEADS, HEAD_DIM), positions) * HEAD_DIM ** -0.5).reshape(shp)
    vc = v.astype(jnp.float32).reshape(shp)
    log_gamma = jnp.log1p(-jnp.exp2(-5.0 - jnp.arange(RET_HEADS, dtype=jnp.float32)))
    idx = jnp.arange(RET_CHUNK, dtype=jnp.float32)
    diff = idx[:, None] - idx[None, :]
    decay = jnp.where(diff >= 0, jnp.exp(log_gamma[:, None, None] * jnp.maximum(diff, 0.0)), 0.0)
    scores = jnp.einsum('bnihd,bnjhd->bnhij', qc, kc) * decay[None, None]
    y_inner = jnp.einsum('bnhij,bnjhd->bnihd', scores, vc)
    k_w = jnp.exp(log_gamma[None, :] * (RET_CHUNK - 1.0 - idx)[:, None])
    u = jnp.einsum('bnjhd,bnjhe,jh->bnhde', kc, vc, k_w)
    chunk_decay = jnp.exp(log_gamma * RET_CHUNK)[None, :, None, None]

    def step(state, u_n):
        return chunk_decay * state + u_n, state

    init = jnp.zeros((bsz, RET_HEADS, HEAD_DIM, HEAD_DIM), jnp.float32)
    _, prev_states = lax.scan(step, init, u.transpose(1, 0, 2, 3, 4))
    q_w = jnp.exp(log_gamma[None, :] * (idx + 1.0)[:, None])
    y_cross = jnp.einsum('bnihd,nbhde,ih->bnihe', qc, prev_states, q_w)
    y = (y_inner + y_cross).reshape(bsz, s, RET_HEADS, HEAD_DIM)
    mu = jnp.mean(y, axis=-1, keepdims=True)
    var = jnp.mean(jnp.square(y - mu), axis=-1, keepdims=True)
    y = ((y - mu) * lax.rsqrt(var + EPS)).reshape(bsz, s, RET_WIDTH)
    return (jax.nn.silu(g.astype(jnp.float32)) * y).astype(g.dtype)


def parallel_mixer(h, positions, w_in, conv_w, conv_b, w_rg, b_rg, w_ig, b_ig, lru_lambda, fox_b_f, w_out):
    proj = h @ w_in
    lx, ly, fq, fk, fv, ff, rq, rk, rv, rg = jnp.split(proj, np.cumsum(SPLIT_SIZES)[:-1].tolist(), axis=-1)
    lru_out = rg_lru(causal_depthwise_conv(lx, conv_w, conv_b), w_rg, b_rg, w_ig, b_ig, lru_lambda) * jax.nn.gelu(ly)
    fox_out = forgetting_attention(fq, fk, fv, ff, fox_b_f)
    ret_out = retention(rq, rk, rv, rg, positions)
    return jnp.concatenate([lru_out, fox_out.astype(h.dtype), ret_out], axis=-1) @ w_out


def memory_cross_attention(h, mem_n, w_q, w_k, w_v, w_o):
    bsz, s, _ = h.shape
    m = mem_n.shape[1]
    q = (h @ w_q).reshape(bsz, s, CROSS_HEADS, CROSS_HEAD_DIM)
    k = (mem_n @ w_k).reshape(bsz, m, CROSS_HEADS, CROSS_HEAD_DIM)
    v = (mem_n @ w_v).reshape(bsz, m, CROSS_HEADS, CROSS_HEAD_DIM)
    logits = jnp.einsum('bshd,bmhd->bhsm', q, k).astype(jnp.float32) * CROSS_HEAD_DIM ** -0.5
    p = jax.nn.softmax(logits, axis=-1)
    o = jnp.einsum('bhsm,bmhd->bshd', p.astype(v.dtype), v).reshape(bsz, s, D_MODEL)
    return o @ w_o


def swiglu(h, w_gate, w_up, w_down):
    return (jax.nn.silu(h @ w_gate) * (h @ w_up)) @ w_down


def setup_inputs(seed: int = 0) -> dict:
    key = jax.random.key(seed)
    ks = jax.random.split(key, 32)

    def nrm(k, shape, scale):
        return scale * jax.random.normal(k, shape, jnp.float32)

    def gain(k, shape):
        return 1.0 + 0.02 * jax.random.normal(k, shape, jnp.float32)

    u = jax.random.uniform(ks[12], (DEPTH, LRU_WIDTH), jnp.float32, 0.9, 0.999)
    a_base = u ** (1.0 / LRU_C)
    lru_lambda = jnp.log(a_base) - jnp.log1p(-a_base)
    return {
        'x': nrm(ks[0], (BATCH, SEQ, D_MODEL), 1.0),
        'mem': nrm(ks[1], (BATCH, MEM_LEN, D_MODEL), 1.0),
        'positions': jnp.tile(jnp.arange(SEQ, dtype=jnp.int32)[None, :], (BATCH, 1)),
        'pre_mix_g': gain(ks[2], (DEPTH, D_MODEL)),
        'post_mix_g': gain(ks[3], (DEPTH, D_MODEL)),
        'w_in': nrm(ks[4], (DEPTH, D_MODEL, IN_WIDTH), D_MODEL ** -0.5),
        'conv_w': nrm(ks[5], (DEPTH, CONV_WIDTH, LRU_WIDTH), CONV_WIDTH ** -0.5),
        'conv_b': nrm(ks[6], (DEPTH, LRU_WIDTH), 0.01),
        'w_rg': nrm(ks[7], (DEPTH, LRU_BLOCKS, LRU_BLOCK, LRU_BLOCK), LRU_BLOCK ** -0.5),
        'b_rg': nrm(ks[8], (DEPTH, LRU_WIDTH), 0.01),
        'w_ig': nrm(ks[9], (DEPTH, LRU_BLOCKS, LRU_BLOCK, LRU_BLOCK), LRU_BLOCK ** -0.5),
        'b_ig': nrm(ks[10], (DEPTH, LRU_WIDTH), 0.01),
        'lru_lambda': lru_lambda,
        'fox_b_f': 2.0 + nrm(ks[11], (DEPTH, FOX_HEADS), 0.5),
        'w_out': nrm(ks[13], (DEPTH, MIX_WIDTH, D_MODEL), MIX_WIDTH ** -0.5),
        'pre_cross_g': gain(ks[14], (DEPTH, D_MODEL)),
        'post_cross_g': gain(ks[15], (DEPTH, D_MODEL)),
        'mem_norm_g': gain(ks[16], (D_MODEL,)),
        'w_cq': nrm(ks[17], (DEPTH, D_MODEL, D_MODEL), D_MODEL ** -0.5),
        'w_ck': nrm(ks[18], (DEPTH, D_MODEL, D_MODEL), D_MODEL ** -0.5),
        'w_cv': nrm(ks[19], (DEPTH, D_MODEL, D_MODEL), D_MODEL ** -0.5),
        'w_co': nrm(ks[20], (DEPTH, D_MODEL, D_MODEL), D_MODEL ** -0.5),
        'pre_ffn_g': gain(ks[21], (DEPTH, D_MODEL)),
        'post_ffn_g': gain(ks[22], (DEPTH, D_MODEL)),
        'w_gate': nrm(ks[23], (DEPTH, D_MODEL, D_FF), D_MODEL ** -0.5),
        'w_up': nrm(ks[24], (DEPTH, D_MODEL, D_FF), D_MODEL ** -0.5),
        'w_down': nrm(ks[25], (DEPTH, D_FF, D_MODEL), D_FF ** -0.5),
    }


def reference(x, mem, positions, pre_mix_g, post_mix_g, w_in, conv_w, conv_b, w_rg, b_rg, w_ig, b_ig, lru_lambda, fox_b_f, w_out, pre_cross_g, post_cross_g, mem_norm_g, w_cq, w_ck, w_cv, w_co, pre_ffn_g, post_ffn_g, w_gate, w_up, w_down):
    mem_n = rms_norm(mem, mem_norm_g)
    for l in range(DEPTH):
        h = rms_norm(x, pre_mix_g[l])
        mix = parallel_mixer(h, positions, w_in[l], conv_w[l], conv_b[l], w_rg[l], b_rg[l], w_ig[l], b_ig[l], lru_lambda[l], fox_b_f[l], w_out[l])
        x = x + rms_norm(mix, post_mix_g[l])
        h = rms_norm(x, pre_cross_g[l])
        x = x + rms_norm(memory_cross_attention(h, mem_n, w_cq[l], w_ck[l], w_cv[l], w_co[l]), post_cross_g[l])
        h = rms_norm(x, pre_ffn_g[l])
        x = x + rms_norm(swiglu(h, w_gate[l], w_up[l], w_down[l]), post_ffn_g[l])
    return x
```

```cpp
#include <hip/hip_runtime.h>
#include <cstdio>
#include <cstdint>
namespace pg8 {
#define PG8_LAS __attribute__((address_space(3)))
typedef unsigned short bf16_t;
typedef short bf16x8 __attribute__((ext_vector_type(8)));
typedef float f32x4 __attribute__((ext_vector_type(4)));
typedef unsigned u32x4 __attribute__((ext_vector_type(4)));
constexpr int BM = 256, BK = 64, HALF = 128, HTB = HALF * BK * 2  , STAGE_BYTES = 8 * HTB, NXCD = 8, WGM = 8;

__host__ __device__ __forceinline__ int lds_byte(int r, int c) { const int st = (r >> 4) * 2 + (c >> 5), rr = r & 15, cc = c & 31, ob = rr * 64 + cc * 2; return st * 1024 + (ob ^ (((ob >> 9) & 1) << 5)); }
__host__ __device__ __forceinline__ void stage_rc(int b, int& R, int& C) { const int st = b / 1024, sb = b % 1024, swz = sb ^ (((sb >> 9) & 1) << 5); R = (st >> 1) * 16 + swz / 64; C = (st & 1) * 32 + (swz % 64) / 2; }
__host__ __device__ __forceinline__ int perm32(int rho) { const int n = rho >> 4, i = rho & 15; return 8 * (i >> 2) + 4 * n + (i & 3); }

struct Unit { int pm, pn; };
struct Gemm { const bf16_t* A; const bf16_t* Bt; int M, N, K; };

struct StaticOrder {
    int nM, nN, nwg, G, c;
    __host__ __device__ void init(int M, int N, int G_, int c_) { nM = M / BM; nN = N / BM; nwg = nM * nN; G = G_; c = c_; }
    __host__ __device__ bool next(int i, Unit& u) const {
        const long L = (long)i * G + c; if (L >= nwg) return false;
        int wgid = (int)L; { const int q = nwg / NXCD, r = nwg % NXCD, xcd = wgid % NXCD, off = wgid / NXCD; wgid = (xcd < r ? xcd * (q + 1) : r * (q + 1) + (xcd - r) * q) + off; }
        const int nig = WGM * nN, gid = wgid / nig, fm = gid * WGM, gsz = (nM - fm) < WGM ? (nM - fm) : WGM;
        u.pm = fm + ((wgid % nig) % gsz); u.pn = (wgid % nig) / gsz; return true;
    }
    __device__ __forceinline__ void a_ready(const Unit&) const {}
    __device__ __forceinline__ void done(const Unit&) const {}
};


typedef float f32x2 __attribute__((ext_vector_type(2)));
typedef __bf16 bf16x2_t __attribute__((ext_vector_type(2)));
__device__ __forceinline__ unsigned cvt_pk_bf16(float lo, float hi) { f32x2 v = {lo, hi}; bf16x2_t b = __builtin_convertvector(v, bf16x2_t); return __builtin_bit_cast(unsigned, b); }

struct EpiPlain {
    static constexpr bool PERM = true, AFTER_DRAIN = false;
    bf16_t* O; int ldc; float sc; int sc_lo, sc_hi;
    __device__ __forceinline__ void operator()(const f32x4 (&acc)[2][2][4][2], const Unit& u, int wr, int wc, int fr, int fq) const {
        const int row0 = u.pm * BM + wr * 64 + fr; const int col0 = u.pn * BM + wc * 32 + 8 * fq;
        const float s = (u.pn >= sc_lo && u.pn < sc_hi) ? sc : 1.f;
#pragma unroll
        for (int ai = 0; ai < 2; ++ai)
#pragma unroll
            for (int m = 0; m < 4; ++m) { bf16_t* rowp = O + (size_t)(row0 + ai * HALF + m * 16) * ldc + col0;
#pragma unroll
                for (int bj = 0; bj < 2; ++bj) { const f32x4 v0 = acc[ai][bj][m][0] * s, v1 = acc[ai][bj][m][1] * s;
                    u32x4 w; w.x = cvt_pk_bf16(v0[0], v0[1]); w.y = cvt_pk_bf16(v0[2], v0[3]); w.z = cvt_pk_bf16(v1[0], v1[1]); w.w = cvt_pk_bf16(v1[2], v1[3]);
                    *(u32x4*)(rowp + bj * HALF) = w; } }
    }
};
struct EpiSwiGLU {
    static constexpr bool PERM = true, AFTER_DRAIN = false;
    bf16_t* O; int ldc;
    __device__ __forceinline__ void operator()(const f32x4 (&acc)[2][2][4][2], const Unit& u, int wr, int wc, int fr, int fq) const {
        const int row0 = u.pm * BM + wr * 64 + fr; const int col0 = u.pn * HALF + wc * 32 + 8 * fq;
#pragma unroll
        for (int ai = 0; ai < 2; ++ai)
#pragma unroll
            for (int m = 0; m < 4; ++m) { bf16_t* rowp = O + (size_t)(row0 + ai * HALF + m * 16) * ldc + col0;
                float o[8];
#pragma unroll
                for (int n = 0; n < 2; ++n)
#pragma unroll
                    for (int i = 0; i < 4; ++i) { const float g = acc[ai][0][m][n][i], up = acc[ai][1][m][n][i];
                        const float sg = g * __builtin_amdgcn_rcpf(1.0f + __builtin_amdgcn_exp2f(-1.4426950408889634f * g)); o[4 * n + i] = sg * up; }
                u32x4 w; w.x = cvt_pk_bf16(o[0], o[1]); w.y = cvt_pk_bf16(o[2], o[3]); w.z = cvt_pk_bf16(o[4], o[5]); w.w = cvt_pk_bf16(o[6], o[7]);
                *(u32x4*)rowp = w; }
    }
};

template <class Epi, class Sched, bool ALIGN_EPI = false, bool SP2 = false>
__device__ __forceinline__ void gemm_phase(PG8_LAS unsigned char* lds, const Gemm g, const Sched& S, const Epi& E) {
    int tid_ = threadIdx.x; asm volatile("" : "+v"(tid_));
    const int tid = tid_, wid = __builtin_amdgcn_readfirstlane(tid >> 6), lane = tid & 63, wr = wid >> 2, wc = wid & 3, fr = lane & 15, fq = lane >> 4;
    const int K = g.K, nt = K / BK;
    unsigned voffA[2], voffB[2];
#pragma unroll
    for (int i = 0; i < 2; ++i) { int R, C; stage_rc(tid * 16 + i * 8192, R, C); const int Rb = Epi::PERM ? ((R & ~31) + perm32(R & 31)) : R;
        voffA[i] = (unsigned)(R * K + C) * 2u; voffB[i] = (unsigned)(Rb * K + C) * 2u; }
    const size_t kstep = (size_t)(BK * 2);
    const size_t hstep = (size_t)HALF * K * 2;
    const size_t tstep = 2 * hstep;
    const unsigned ldsw = (unsigned)wid * 1024u;
    const int aoff = lds_byte(wr * 64 + fr, fq * 8), boff = lds_byte(wc * 32 + fr, fq * 8);
#define PG8_SA(b, h) (((b) * 2 + (h)) * HTB)
#define PG8_SB(b, h) ((4 + (b) * 2 + (h)) * HTB)
#define PG8_STAGE(bufoff, gbase, voff) do { _Pragma("unroll") for (int _i = 0; _i < 2; ++_i) \
        __builtin_amdgcn_global_load_lds((const unsigned*)((const char*)(gbase) + (voff)[_i]), (PG8_LAS unsigned*)(lds + (bufoff) + ldsw + _i * 8192), 16, 0, 0); } while (0)
#define PG8_LDA(dst, b, h) do { _Pragma("unroll") for (int m = 0; m < 4; ++m) _Pragma("unroll") for (int k = 0; k < 2; ++k) dst[m][k] = *(const PG8_LAS bf16x8*)(lds + PG8_SA(b, h) + aoff + m * 2048 + k * 1024); } while (0)
#define PG8_LDB(dst, b, h) do { _Pragma("unroll") for (int n = 0; n < 2; ++n) _Pragma("unroll") for (int k = 0; k < 2; ++k) dst[n][k] = *(const PG8_LAS bf16x8*)(lds + PG8_SB(b, h) + boff + n * 2048 + k * 1024); } while (0)
#define PG8_MMA(ai, bj, At, Bt) do { __builtin_amdgcn_s_setprio(1); _Pragma("unroll") for (int m = 0; m < 4; ++m) _Pragma("unroll") for (int n = 0; n < 2; ++n) _Pragma("unroll") for (int k = 0; k < 2; ++k) \
        acc[ai][bj][m][n] = __builtin_amdgcn_mfma_f32_16x16x32_bf16(Bt[n][k], At[m][k], acc[ai][bj][m][n], 0, 0, 0); __builtin_amdgcn_s_setprio(0); } while (0)
#define PG8_WAIT_V(n) asm volatile("s_waitcnt vmcnt(" #n ")" ::: "memory")
#define PG8_WAIT_L(n) asm volatile("s_waitcnt lgkmcnt(" #n ")" ::: "memory")
#define PG8_BAR __builtin_amdgcn_s_barrier()
#define PG8_SCHED __builtin_amdgcn_sched_barrier(0)
    Unit cur, nxt; int ui = 0;
    if (!S.next(0, cur)) return;
    f32x4 acc[2][2][4][2];
#pragma unroll
    for (int a = 0; a < 2; ++a)
#pragma unroll
        for (int b = 0; b < 2; ++b)
#pragma unroll
            for (int m = 0; m < 4; ++m)
#pragma unroll
                for (int n = 0; n < 2; ++n) acc[a][b][m][n] = (f32x4){0.f, 0.f, 0.f, 0.f};
    bf16x8 At[4][2], B0[2][2], B1[2][2];
    const char* cA = (const char*)g.A + (size_t)cur.pm * tstep; const char* cB = (const char*)g.Bt + (size_t)cur.pn * tstep;
    S.a_ready(cur);
    if constexpr (SP2) {
        PG8_STAGE(PG8_SB(0, 0), cB, voffB); PG8_STAGE(PG8_SB(0, 1), cB + hstep, voffB); PG8_STAGE(PG8_SA(0, 0), cA, voffA); PG8_STAGE(PG8_SA(0, 1), cA + hstep, voffA);
        if (wr == 1) PG8_BAR;
        PG8_WAIT_V(2); PG8_BAR;
        PG8_STAGE(PG8_SB(1, 0), cB + kstep, voffB); PG8_STAGE(PG8_SA(1, 0), cA + kstep, voffA); PG8_STAGE(PG8_SB(1, 1), cB + hstep + kstep, voffB);
        PG8_WAIT_V(6); PG8_BAR;
    } else {
        PG8_STAGE(PG8_SB(0, 0), cB, voffB); PG8_STAGE(PG8_SA(0, 0), cA, voffA); PG8_STAGE(PG8_SB(0, 1), cB + hstep, voffB); PG8_STAGE(PG8_SA(0, 1), cA + hstep, voffA);
        if (wr == 1) PG8_BAR;
        PG8_WAIT_V(4); PG8_BAR;
        PG8_STAGE(PG8_SB(1, 0), cB + kstep, voffB); PG8_STAGE(PG8_SA(1, 0), cA + kstep, voffA); PG8_STAGE(PG8_SB(1, 1), cB + hstep + kstep, voffB);
        PG8_WAIT_V(6); PG8_BAR;
    }
    for (;;) {
        const bool has_next = S.next(ui + 1, nxt);
        const char* nA = has_next ? (const char*)g.A + (size_t)nxt.pm * tstep : cA; const char* nB = has_next ? (const char*)g.Bt + (size_t)nxt.pn * tstep : cB;
        for (int t = 0; t < nt; t += 2) {
            const bool last = (t == nt - 2);
            const char* a1 = cA + (size_t)(t + 1) * kstep;
            const char* a2 = last ? nA : cA + (size_t)(t + 2) * kstep; const char* b2 = last ? nB : cB + (size_t)(t + 2) * kstep;
            const char* a3 = a2 + kstep; const char* b3 = b2 + kstep;
            if (last && has_next) S.a_ready(nxt);
            if constexpr (SP2) {
            PG8_LDB(B0, 0, 0); PG8_LDB(B1, 0, 1); PG8_SCHED; PG8_LDA(At, 0, 0); PG8_STAGE(PG8_SA(1, 1), a1 + hstep, voffA);
            PG8_WAIT_V(8); PG8_WAIT_L(0); PG8_BAR; PG8_MMA(0, 0, At, B0); PG8_MMA(0, 1, At, B1); PG8_BAR; PG8_SCHED;
            PG8_LDA(At, 0, 1); PG8_STAGE(PG8_SB(0, 0), b2, voffB); PG8_STAGE(PG8_SB(0, 1), b2 + hstep, voffB); PG8_STAGE(PG8_SA(0, 0), a2, voffA);
            PG8_WAIT_V(8); PG8_WAIT_L(0); PG8_BAR; PG8_MMA(1, 0, At, B0); PG8_MMA(1, 1, At, B1); PG8_BAR; PG8_SCHED;
            PG8_LDB(B0, 1, 0); PG8_LDB(B1, 1, 1); PG8_SCHED; PG8_LDA(At, 1, 0); PG8_STAGE(PG8_SA(0, 1), a2 + hstep, voffA);
            PG8_WAIT_V(8); PG8_WAIT_L(0); PG8_BAR; PG8_MMA(0, 0, At, B0); PG8_MMA(0, 1, At, B1); PG8_BAR; PG8_SCHED;
            PG8_LDA(At, 1, 1); PG8_STAGE(PG8_SB(1, 0), b3, voffB); PG8_STAGE(PG8_SB(1, 1), b3 + hstep, voffB); PG8_STAGE(PG8_SA(1, 0), a3, voffA);
            PG8_WAIT_V(8); PG8_WAIT_L(0); PG8_BAR; PG8_MMA(1, 0, At, B0); PG8_MMA(1, 1, At, B1); PG8_BAR; PG8_SCHED;
            } else {
            PG8_LDB(B0, 0, 0); PG8_SCHED; PG8_LDA(At, 0, 0); PG8_STAGE(PG8_SA(1, 1), a1 + hstep, voffA);
            PG8_WAIT_L(8); PG8_BAR; PG8_WAIT_L(0); PG8_MMA(0, 0, At, B0); PG8_BAR; PG8_SCHED;
            PG8_LDB(B1, 0, 1); PG8_STAGE(PG8_SB(0, 0), b2, voffB);
            PG8_BAR; PG8_WAIT_L(0); PG8_MMA(0, 1, At, B1); PG8_BAR;
            PG8_LDA(At, 0, 1); PG8_STAGE(PG8_SA(0, 0), a2, voffA);
            PG8_BAR; PG8_WAIT_L(0); PG8_MMA(1, 0, At, B0); PG8_BAR; PG8_SCHED;
            PG8_STAGE(PG8_SB(0, 1), b2 + hstep, voffB);
            PG8_WAIT_V(6); PG8_BAR; PG8_MMA(1, 1, At, B1); PG8_BAR;
            PG8_LDB(B0, 1, 0); PG8_SCHED; PG8_LDA(At, 1, 0); PG8_STAGE(PG8_SA(0, 1), a2 + hstep, voffA);
            PG8_WAIT_L(8); PG8_BAR; PG8_WAIT_L(0); PG8_MMA(0, 0, At, B0); PG8_BAR; PG8_SCHED;
            PG8_LDB(B1, 1, 1); PG8_STAGE(PG8_SB(1, 0), b3, voffB);
            PG8_BAR; PG8_WAIT_L(0); PG8_MMA(0, 1, At, B1); PG8_BAR;
            PG8_LDA(At, 1, 1); PG8_STAGE(PG8_SA(1, 0), a3, voffA);
            PG8_BAR; PG8_WAIT_L(0); PG8_MMA(1, 0, At, B0); PG8_BAR; PG8_SCHED;
            PG8_STAGE(PG8_SB(1, 1), b3 + hstep, voffB);
            PG8_WAIT_V(6); PG8_BAR; PG8_MMA(1, 1, At, B1); PG8_BAR;
            }
        }
        if constexpr (ALIGN_EPI) { if (wr == 0) PG8_BAR; }
        if constexpr (!Epi::AFTER_DRAIN) { E(acc, cur, wr, wc, fr, fq); S.done(cur); }
        if (!has_next) break;
#pragma unroll
        for (int a = 0; a < 2; ++a)
#pragma unroll
            for (int b = 0; b < 2; ++b)
#pragma unroll
                for (int m = 0; m < 4; ++m)
#pragma unroll
                    for (int n = 0; n < 2; ++n) acc[a][b][m][n] = (f32x4){0.f, 0.f, 0.f, 0.f};
        cur = nxt; cA = nA; cB = nB; ++ui;
        if constexpr (ALIGN_EPI) { if (wr == 1) PG8_BAR; }
    }
    PG8_WAIT_V(0);
    if constexpr (!ALIGN_EPI) { if (wr == 0) PG8_BAR; }
    PG8_BAR;
    if constexpr (Epi::AFTER_DRAIN) { E.fused(acc, cur, wr, wc, fr, fq, lds, wid, lane); S.done(cur); }
#undef PG8_SA
#undef PG8_SB
#undef PG8_STAGE
#undef PG8_LDA
#undef PG8_LDB
#undef PG8_MMA
#undef PG8_WAIT_V
#undef PG8_WAIT_L
#undef PG8_BAR
#undef PG8_SCHED
}
}

constexpr int NWAVES = 8;
constexpr int BATCH = 2, SEQ = 16384, M = BATCH * SEQ, D = 1024, NPROJ = 3072, INW = 3080, DFF = 2816, MEML = 256;
constexpr int C_LX = 0, C_LY = 256, C_FQ = 512, C_FK = 1024, C_FV = 1536, C_RQ = 2048, C_RK = 2304, C_RV = 2560, C_RG = 2816;
constexpr float EPS = 1e-6f;
constexpr float LOG2E = 1.4426950408889634f;
constexpr float C2FOX = 0.125f * 1.4426950408889634f;
constexpr float C2CROSS = 0.0625f * 1.4426950408889634f;
#ifndef FOX_PRUNE
#define FOX_PRUNE 0
#endif

constexpr size_t MiB = 1u << 20, KiB = 1u << 10;
constexpr size_t WS_CTL = 0, CTL_ZERO_BYTES = 1 * MiB;
constexpr size_t WS_WGT = 1 * MiB;
constexpr size_t WS_LRUSP = WS_WGT + 128 * KiB;
constexpr size_t WS_FOXMAX = WS_LRUSP + 4 * KiB;
constexpr size_t WS_MEMN = 2 * MiB;
constexpr size_t WS_LFT = 3 * MiB;
constexpr size_t WS_C2 = 4 * MiB;
constexpr size_t WS_CARA = 5 * MiB, WS_CARH = WS_CARA + 512 * KiB, WS_CARIN = 6 * MiB;
constexpr size_t WS_KMEM = 7 * MiB;
constexpr size_t WS_VTMEM = 9 * MiB;
constexpr size_t WS_W = 12 * MiB;
constexpr size_t W_IN = 0, W_OUT = W_IN + (size_t)NPROJ * D * 2, W_CQ = W_OUT + (size_t)D * D * 2, W_CO = W_CQ + (size_t)D * D * 2,
                 W_GU = W_CO + (size_t)D * D * 2, W_DN = W_GU + (size_t)2 * DFF * D * 2, W_LAYER = W_DN + (size_t)D * DFF * 2;
constexpr size_t WS_WCK = WS_W + 2 * W_LAYER, WS_WCV = WS_WCK + (size_t)2 * D * D * 2, WS_WEND = WS_WCV + (size_t)2 * D * D * 2;
constexpr size_t WS_H = 77 * MiB;
constexpr size_t WS_BIG = 141 * MiB;
constexpr size_t WS_AU = 333 * MiB;
constexpr size_t WS_KWT = 397 * MiB, WS_RVT = 413 * MiB, WS_FVT = 429 * MiB;
constexpr size_t WS_UT = 461 * MiB, WS_PREV = 477 * MiB, WS_END = 485 * MiB;
static_assert(WS_WEND <= WS_H && WS_H + (size_t)M * D * 2 <= WS_BIG && WS_BIG + (size_t)M * NPROJ * 2 <= WS_AU && WS_AU + (size_t)M * 256 * 8 <= WS_KWT, "ws map");
constexpr int CW_BAR = 4096;

constexpr int RING_OFF = 0, RING_BYTES = 131072;
constexpr int LDSCTL_OFF = RING_BYTES, MISC_OFF = LDSCTL_OFF + 320;
constexpr int LDS_BYTES = 147456;

#define GAS __attribute__((address_space(1)))
#define LAS __attribute__((address_space(3)))
typedef unsigned short bf16;
typedef unsigned v4u __attribute__((ext_vector_type(4)));
typedef unsigned v2u __attribute__((ext_vector_type(2)));
typedef float f32x4 __attribute__((ext_vector_type(4)));
typedef float f32x16 __attribute__((ext_vector_type(16)));
typedef short bf16x8 __attribute__((ext_vector_type(8)));
typedef GAS unsigned gu32;
#define RLX_AGENT __ATOMIC_RELAXED, __HIP_MEMORY_SCOPE_AGENT
#define LDS_WAIT() asm volatile("s_waitcnt lgkmcnt(0)" ::: "memory")
#define VM_WAIT() asm volatile("s_waitcnt vmcnt(0)" ::: "memory")
#define MFMA32(a, b, c) __builtin_amdgcn_mfma_f32_32x32x16_bf16((a), (b), (c), 0, 0, 0)
__device__ __forceinline__ unsigned pk2(float lo, float hi) { return pg8::cvt_pk_bf16(lo, hi); }
__device__ __forceinline__ float bflo(unsigned w) { return __uint_as_float(w << 16); }
__device__ __forceinline__ float bfhi(unsigned w) { return __uint_as_float(w & 0xffff0000u); }
__device__ __forceinline__ int crow(int r, int hi) { return (r & 3) + 8 * (r >> 2) + 4 * hi; }
__device__ __forceinline__ int swap23(int r) { return (r & 0x13) | ((r & 4) << 1) | ((r & 8) >> 1); }
__device__ __forceinline__ bf16x8 ld8(const bf16* p) { return *(const bf16x8*)p; }
__device__ __forceinline__ bf16x8 pack8(const f32x16& x, int s) {
    v4u p; p.x = pk2(x[8 * s], x[8 * s + 1]); p.y = pk2(x[8 * s + 2], x[8 * s + 3]); p.z = pk2(x[8 * s + 4], x[8 * s + 5]); p.w = pk2(x[8 * s + 6], x[8 * s + 7]);
    return __builtin_bit_cast(bf16x8, p); }
__device__ __forceinline__ float wave_sum(float v) {
#pragma unroll
    for (int o = 1; o < 64; o <<= 1) v += __shfl_xor(v, o);
    return v;
}
__device__ __forceinline__ float sigmoidf_(float x) { return __builtin_amdgcn_rcpf(1.0f + __builtin_amdgcn_exp2f(-LOG2E * x)); }
__device__ __forceinline__ float lg2gamma(int h) { return h == 0 ? -0.04580368961312479f : h == 1 ? -0.02272007650008353f : h == 2 ? -0.011315313227834146f : -0.005646563141142063f; }

#define XB_TMO      128
#define XB_XCNT(j)  (256  + 64 * (j))
#define XB_XSUB(j)  (1280 + 64 * (j))
#define XB_XGEN(j)  (2304 + 64 * (j))
#define XB_TOP      3328
#define XB_TOPGEN   3392
#define XCD_BAR_WORDS 3456
#define XB_SPIN_CAP (1u << 18)

__device__ __forceinline__ unsigned xb_ld(unsigned* p)              { return __hip_atomic_load(p, __ATOMIC_RELAXED, __HIP_MEMORY_SCOPE_AGENT); }
__device__ __forceinline__ unsigned xb_add(unsigned* p, unsigned v) { return __hip_atomic_fetch_add(p, v, __ATOMIC_RELAXED, __HIP_MEMORY_SCOPE_AGENT); }
__device__ __forceinline__ unsigned xb_xcc_id() { return (unsigned)__builtin_amdgcn_s_getreg((3 << 11) | 20) & 0xFu; }
#define XB_SPIN(cond, bar) do { unsigned _sp = 0; while (cond) { __builtin_amdgcn_s_sleep(1); \
    if ((++_sp & 255u) == 0u) { if (xb_ld(&(bar)[XB_TMO])) break; if (_sp > XB_SPIN_CAP) { atomicAdd(&(bar)[XB_TMO], 1u); break; } } } } while (0)

struct XcdBarrier {
    unsigned* bar; unsigned x;
    volatile LAS unsigned* st;
};

__device__ __forceinline__ XcdBarrier xcd_barrier_post(unsigned* bar, volatile LAS unsigned* st) {
    XcdBarrier b; b.bar = bar; b.x = xb_xcc_id(); b.st = st;
    if (threadIdx.x == 0) (void)xb_add(&bar[XB_XCNT(b.x)], 1u);
    return b;
}
__device__ __forceinline__ void xcd_barrier_complete(unsigned* bar, unsigned x, unsigned& nloc, unsigned& nx) {
    const unsigned G = gridDim.x * gridDim.y * gridDim.z;
    unsigned sum, cnt, mine, sp = 0u;
    for (;;) {
        sum = 0u; cnt = 0u; mine = 0u;
#pragma unroll
        for (unsigned j = 0; j < 16; ++j) { const unsigned c = xb_ld(&bar[XB_XCNT(j)]); sum += c; cnt += (c > 0u) ? 1u : 0u; mine = (j == x) ? c : mine; }
        if (sum == G) break;
        __builtin_amdgcn_s_sleep(1);
        if ((++sp & 255u) == 0u) { if (xb_ld(&bar[XB_TMO])) break; if (sp > XB_SPIN_CAP) { atomicAdd(&bar[XB_TMO], 1u); break; } }
    }
    nloc = mine > 0u ? mine : 1u; nx = cnt > 0u ? cnt : 1u;
}

__device__ __forceinline__ void xcd_barrier(const XcdBarrier& b) {
    asm volatile("s_waitcnt vmcnt(0)" ::: "memory");
    __syncthreads();
    if (threadIdx.x == 0) {
        unsigned* bar = b.bar;
        __builtin_amdgcn_s_waitcnt(0);
        unsigned nloc = b.st[0], nx = b.st[1];
        if (nloc == 0u) { xcd_barrier_complete(bar, b.x, nloc, nx); b.st[0] = nloc; b.st[1] = nx; }
        const unsigned old = xb_add(&bar[XB_XSUB(b.x)], 1u);
        const unsigned gen = old / nloc;
        if (old + 1u == (gen + 1u) * nloc) {
            __builtin_amdgcn_fence(__ATOMIC_RELEASE, "agent");
            asm volatile("s_waitcnt vmcnt(0)" ::: "memory");
            const unsigned og = xb_add(&bar[XB_TOP], 1u);
            const unsigned tg = og / nx;
            if (og + 1u == (tg + 1u) * nx) xb_add(&bar[XB_TOPGEN], 1u);
            else XB_SPIN(xb_ld(&bar[XB_TOPGEN]) == tg, bar);
            __builtin_amdgcn_fence(__ATOMIC_ACQUIRE, "agent");
            xb_add(&bar[XB_XGEN(b.x)], 1u);
            asm volatile("s_waitcnt vmcnt(0)" ::: "memory");
        } else {
            XB_SPIN(xb_ld(&bar[XB_XGEN(b.x)]) == gen, bar);
            __builtin_amdgcn_fence(__ATOMIC_ACQUIRE, "agent");
            asm volatile("s_waitcnt vmcnt(0)" ::: "memory");
        }
    }
    __syncthreads();
}

struct Args { const float* in[27]; float* out; unsigned char* ws; };
struct Frame {
    LAS unsigned char* lds;
    volatile LAS unsigned* MISC;
    gu32* ctl;
    int tid, lane, wave;
    int G, gw, NGW;
    unsigned char* ws;
};

__device__ __forceinline__ void transpose_item(const float* W, int ldw, int k0, int n0, bf16* WT, int K, int dn0, LAS float* scr, int lane) {
#pragma unroll 8
    for (int i = 0; i < 32; ++i) { const int kk = 2 * i + (lane >> 5); scr[kk * 33 + (lane & 31)] = W[(size_t)(k0 + kk) * ldw + n0 + (lane & 31)]; }
    LDS_WAIT(); asm volatile("" ::: "memory");
    const int c = lane & 7;
#pragma unroll
    for (int j = 0; j < 4; ++j) { const int n = (lane >> 3) + 8 * j; const LAS float* s = scr + (8 * c) * 33 + n;
        v4u o; o.x = pk2(s[0 * 33], s[1 * 33]); o.y = pk2(s[2 * 33], s[3 * 33]); o.z = pk2(s[4 * 33], s[5 * 33]); o.w = pk2(s[6 * 33], s[7 * 33]);
        *(GAS v4u*)(WT + (size_t)(dn0 + n) * K + k0 + 8 * c) = o; }
    LDS_WAIT(); asm volatile("" ::: "memory");
}
__device__ __forceinline__ int conv_matrix(Frame& F, LAS float* scr, int it0, int it, const float* W, int ldw, int K, int csrc0, int ncols, bf16* WT, int drow0, int mode) {
    const int nblk = ncols / 32, nitems = (K / 64) * nblk;
    const int r = it - it0;
    if (r >= 0 && r < nitems) {
        const int kb = r / nblk, nb = r % nblk; int n0 = csrc0 + 32 * nb, dn0;
        if (mode == 0) dn0 = drow0 + 32 * nb;
        else if (mode == 1) { dn0 = 32 * nb; if (dn0 >= 2048) n0 += 8; }
        else { const int j = 32 * nb; dn0 = 256 * (j / 128) + 128 * (mode - 2) + (j % 128); }
        transpose_item(W, ldw, 64 * kb, n0, WT, K, dn0, scr, F.lane);
    }
    return it0 + nitems;
}

template <bool HAS_RAW, bool HAS_H, bool HAS_FF>
__device__ __forceinline__ void thin_pass(Frame& F, const bf16* raw, const float* xin, float* xout, const float* gpost, const float* gpre, bf16* hout,
                                          const float* win_l  , const float* bfox, float* lfT) {
    LAS float* wfT = (LAS float*)(F.lds + RING_OFF);
    if (HAS_FF) {
        for (int k = F.tid; k < D; k += NWAVES * 64) { const f32x4 a = *(const f32x4*)(win_l + (size_t)k * INW + 2048), b = *(const f32x4*)(win_l + (size_t)k * INW + 2052);
            wfT[0 * D + k] = a[0]; wfT[1 * D + k] = a[1]; wfT[2 * D + k] = a[2]; wfT[3 * D + k] = a[3]; wfT[4 * D + k] = b[0]; wfT[5 * D + k] = b[1]; wfT[6 * D + k] = b[2]; wfT[7 * D + k] = b[3]; }
        __syncthreads();
    }
    f32x4 gp[4], gq[4];
#pragma unroll
    for (int j = 0; j < 4; ++j) { gp[j] = HAS_RAW ? *(const f32x4*)(gpost + 4 * F.lane + 256 * j) : (f32x4){0.f, 0.f, 0.f, 0.f}; gq[j] = HAS_H ? *(const f32x4*)(gpre + 4 * F.lane + 256 * j) : (f32x4){0.f, 0.f, 0.f, 0.f}; }
    for (int row = F.gw; row < M; row += F.NGW) {
        f32x4 x[4];
#pragma unroll
        for (int j = 0; j < 4; ++j) x[j] = *(const f32x4*)(xin + (size_t)row * D + 4 * F.lane + 256 * j);
        if (HAS_RAW) {
            f32x4 rw[4]; float ss = 0.f;
#pragma unroll
            for (int j = 0; j < 4; ++j) { const v2u w = *(const v2u*)(raw + (size_t)row * D + 4 * F.lane + 256 * j); rw[j] = (f32x4){bflo(w.x), bfhi(w.x), bflo(w.y), bfhi(w.y)};
                ss += (rw[j][0] * rw[j][0] + rw[j][1] * rw[j][1]) + (rw[j][2] * rw[j][2] + rw[j][3] * rw[j][3]); }
            const float rstd = 1.0f / sqrtf(wave_sum(ss) * (1.0f / D) + EPS);
#pragma unroll
            for (int j = 0; j < 4; ++j) x[j] = x[j] + rw[j] * rstd * gp[j];
        }
#pragma unroll
        for (int j = 0; j < 4; ++j) *(f32x4*)(xout + (size_t)row * D + 4 * F.lane + 256 * j) = x[j];
        if (HAS_H) {
            float ss = 0.f;
#pragma unroll
            for (int j = 0; j < 4; ++j) ss += (x[j][0] * x[j][0] + x[j][1] * x[j][1]) + (x[j][2] * x[j][2] + x[j][3] * x[j][3]);
            const float rstd = 1.0f / sqrtf(wave_sum(ss) * (1.0f / D) + EPS);
#pragma unroll
            for (int j = 0; j < 4; ++j) { x[j] = x[j] * rstd * gq[j]; v2u w; w.x = pk2(x[j][0], x[j][1]); w.y = pk2(x[j][2], x[j][3]); *(v2u*)(hout + (size_t)row * D + 4 * F.lane + 256 * j) = w; }
            if (HAS_FF) {
                float ff[8];
#pragma unroll
                for (int q = 0; q < 8; ++q) { float a = 0.f;
#pragma unroll
                    for (int j = 0; j < 4; ++j) { const f32x4 w = *(const LAS f32x4*)(wfT + q * D + 4 * F.lane + 256 * j); a += (x[j][0] * w[0] + x[j][1] * w[1]) + (x[j][2] * w[2] + x[j][3] * w[3]); }
                    ff[q] = wave_sum(a); }
                float mine = 0.f;
#pragma unroll
                for (int q = 0; q < 8; ++q) if (F.lane == q) mine = ff[q];
                if (F.lane < 8) { const float z = mine + bfox[F.lane]; const float lf = fminf(z, 0.f) - log1pf(expf(-fabsf(z)));
                    const int b = row / SEQ, t = row % SEQ; lfT[((size_t)b * 8 + F.lane) * SEQ + t] = lf; }
            }
        }
    }
}

__device__ __forceinline__ void cscan_job(Frame& F, const float* lfT, float* c2, int bh) {
    LAS double* tot = (LAS double*)(F.lds + RING_OFF);
    const float* src = lfT + (size_t)bh * SEQ + 32 * F.tid; float* dst = c2 + (size_t)bh * SEQ + 32 * F.tid;
    float v[32];
#pragma unroll
    for (int j = 0; j < 8; ++j) { const f32x4 a = *(const f32x4*)(src + 4 * j); v[4 * j] = a[0]; v[4 * j + 1] = a[1]; v[4 * j + 2] = a[2]; v[4 * j + 3] = a[3]; }
#pragma unroll
    for (int j = 1; j < 32; ++j) v[j] += v[j - 1];
    double incl = (double)v[31];
#pragma unroll
    for (int o = 1; o < 64; o <<= 1) { const double t = __shfl_up(incl, o); if (F.lane >= o) incl += t; }
    if (F.lane == 63) tot[F.wave] = incl;
    __syncthreads();
    double off = incl - (double)v[31];
    for (int w = 0; w < F.wave; ++w) off += tot[w];
#pragma unroll
    for (int j = 0; j < 8; ++j) { f32x4 o; o[0] = (float)((off + (double)v[4 * j]) * 1.4426950408889634); o[1] = (float)((off + (double)v[4 * j + 1]) * 1.4426950408889634);
        o[2] = (float)((off + (double)v[4 * j + 2]) * 1.4426950408889634); o[3] = (float)((off + (double)v[4 * j + 3]) * 1.4426950408889634); *(f32x4*)(dst + 4 * j) = o; }
    __syncthreads();
}

__device__ __forceinline__ void lru_gates_unit(Frame& F, int unit, const bf16* proj, const float* convw, const float* convb, const bf16* wgt  ,
                                               const float* brg, const float* big, const float* sp, float* Aout, float* Uout) {
    const int r = F.lane & 31, h2 = F.lane >> 5;
    const int m = unit * 32 + r, tl = m % SEQ;
    for (int blk = 0; blk < 4; ++blk) {
        bf16x8 xcf[4];
#pragma unroll
        for (int s = 0; s < 4; ++s) {
            const int cb = 64 * blk + 16 * s + 8 * h2;
            float xc[8];
            { const f32x4 b0 = *(const f32x4*)(convb + cb), b1 = *(const f32x4*)(convb + cb + 4); xc[0] = b0[0]; xc[1] = b0[1]; xc[2] = b0[2]; xc[3] = b0[3]; xc[4] = b1[0]; xc[5] = b1[1]; xc[6] = b1[2]; xc[7] = b1[3]; }
#pragma unroll
            for (int k = 0; k < 4; ++k) {
                if (tl - 3 + k >= 0) {
                    const v4u w = *(const v4u*)(proj + (size_t)(m - 3 + k) * NPROJ + C_LX + cb);
                    const f32x4 c0 = *(const f32x4*)(convw + k * 256 + cb), c1 = *(const f32x4*)(convw + k * 256 + cb + 4);
                    xc[0] += c0[0] * bflo(w.x); xc[1] += c0[1] * bfhi(w.x); xc[2] += c0[2] * bflo(w.y); xc[3] += c0[3] * bfhi(w.y);
                    xc[4] += c1[0] * bflo(w.z); xc[5] += c1[1] * bfhi(w.z); xc[6] += c1[2] * bflo(w.w); xc[7] += c1[3] * bfhi(w.w);
                }
            }
            v4u p; p.x = pk2(xc[0], xc[1]); p.y = pk2(xc[2], xc[3]); p.z = pk2(xc[4], xc[5]); p.w = pk2(xc[6], xc[7]);
            xcf[s] = __builtin_bit_cast(bf16x8, p);
        }
        f32x16 Gr[2], Gi[2];
#pragma unroll
        for (int jt = 0; jt < 2; ++jt) { Gr[jt] = (f32x16){}; Gi[jt] = (f32x16){}; }
#pragma unroll
        for (int jt = 0; jt < 2; ++jt)
#pragma unroll
            for (int s = 0; s < 4; ++s) {
                const bf16x8 wr_ = ld8(wgt + ((size_t)(0 * 4 + blk) * 64 + 32 * jt + r) * 64 + 16 * s + 8 * h2);
                const bf16x8 wi_ = ld8(wgt + ((size_t)(1 * 4 + blk) * 64 + 32 * jt + r) * 64 + 16 * s + 8 * h2);
                Gr[jt] = MFMA32(wr_, xcf[s], Gr[jt]); Gi[jt] = MFMA32(wi_, xcf[s], Gi[jt]);
            }
#pragma unroll
        for (int jt = 0; jt < 2; ++jt)
#pragma unroll
            for (int g = 0; g < 4; ++g) {
                const int ch = 64 * blk + 32 * jt + 8 * g + 4 * h2;
                f32x4 xc = *(const f32x4*)(convb + ch);
#pragma unroll
                for (int k = 0; k < 4; ++k) {
                    if (tl - 3 + k >= 0) {
                        const v2u w = *(const v2u*)(proj + (size_t)(m - 3 + k) * NPROJ + C_LX + ch);
                        const f32x4 c0 = *(const f32x4*)(convw + k * 256 + ch);
                        xc[0] += c0[0] * bflo(w.x); xc[1] += c0[1] * bfhi(w.x); xc[2] += c0[2] * bflo(w.y); xc[3] += c0[3] * bfhi(w.y);
                    }
                }
                const f32x4 br = *(const f32x4*)(brg + ch), bi = *(const f32x4*)(big + ch), s8 = *(const f32x4*)(sp + ch);
                f32x4 av, uv;
#pragma unroll
                for (int i = 0; i < 4; ++i) {
                    const float rg = sigmoidf_(Gr[jt][4 * g + i] + br[i]), ig = sigmoidf_(Gi[jt][4 * g + i] + bi[i]);
                    const float la = -rg * s8[i]; const float a = __builtin_amdgcn_exp2f(LOG2E * la);
                    av[i] = a; uv[i] = sqrtf(fmaxf(fmaf(-a, a, 1.0f), 0.f)) * (ig * xc[i]);
                }
                *(f32x4*)(Aout + (size_t)m * 256 + ch) = av; *(f32x4*)(Uout + (size_t)m * 256 + ch) = uv;
            }
    }
}

__device__ __forceinline__ float invfreq(int c, int e) {
    const float t[32] = {1.0f, 0.7498942017555237f, 0.5623413324356079f, 0.4216965138912201f, 0.3162277638912201f, 0.23713737726211548f, 0.17782793939113617f, 0.1333521455526352f,
        0.10000000149011612f, 0.0749894231557846f, 0.05623413249850273f, 0.04216964915394783f, 0.03162277489900589f, 0.023713737726211548f, 0.017782794311642647f, 0.013335213996469975f,
        0.009999999776482582f, 0.007498942315578461f, 0.005623413249850273f, 0.0042169648222625256f, 0.003162277629598975f, 0.0023713738191872835f, 0.0017782794311642647f, 0.0013335214462131262f,
        0.0010000000474974513f, 0.0007498941849917173f, 0.000562341301701963f, 0.0004216965171508491f, 0.0003162277571391314f, 0.00023713737027719617f, 0.00017782794020604342f, 0.0001333521504420787f};
    return c == 0 ? t[e] : c == 1 ? t[8 + e] : c == 2 ? t[16 + e] : t[24 + e];
}
__device__ __forceinline__ void prep_unit(Frame& F, int tt, int jb, bf16* proj, const int* positions, bf16* kwT, bf16* rvT, bf16* fvT) {
    LAS bf16* T = (LAS bf16*)(F.lds + RING_OFF + F.wave * 9216);
    const int m0 = 64 * tt, rr = F.lane >> 2, c = F.lane & 3;
    int scol, h; bf16* dT = nullptr;
    if (jb < 4) { h = jb; scol = C_RQ + 64 * h; }
    else if (jb < 8) { h = jb - 4; scol = C_RK + 64 * h; dT = kwT + (size_t)(64 * h) * M; }
    else if (jb < 12) { h = jb - 8; scol = C_RV + 64 * h; dT = rvT + (size_t)(64 * h) * M; }
    else { h = jb - 12; scol = C_FV + 64 * h; dT = fvT + (size_t)(64 * h) * M; }
    const bool rot = jb < 8, isk = (jb >= 4 && jb < 8);
    const float lgk = lg2gamma(h);
#pragma unroll
    for (int it = 0; it < 4; ++it) {
        const int row = 16 * it + rr, m = m0 + row;
        bf16* p = proj + (size_t)m * NPROJ + scol + 8 * c;
        const v4u w1 = *(const v4u*)p, w2 = *(const v4u*)(p + 32);
        float x1[8] = {bflo(w1.x), bfhi(w1.x), bflo(w1.y), bfhi(w1.y), bflo(w1.z), bfhi(w1.z), bflo(w1.w), bfhi(w1.w)};
        float x2[8] = {bflo(w2.x), bfhi(w2.x), bflo(w2.y), bfhi(w2.y), bflo(w2.z), bfhi(w2.z), bflo(w2.w), bfhi(w2.w)};
        float wt = 1.0f;
        if (rot) {
            const float pos = (float)positions[m];
#pragma unroll
            for (int e = 0; e < 8; ++e) {
                const float ang = pos * invfreq(c, e);
                const double rev = (double)ang * 0.15915494309189535; const float fr = (float)(rev - __builtin_rint(rev));
                const float sn = __builtin_amdgcn_sinf(fr), cs = __builtin_amdgcn_cosf(fr);
                const float a = x1[e], b = x2[e]; x1[e] = a * cs - b * sn; x2[e] = a * sn + b * cs;
            }
            if (isk) {
#pragma unroll
                for (int e = 0; e < 8; ++e) { x1[e] *= 0.125f; x2[e] *= 0.125f; }
                wt = __builtin_amdgcn_exp2f((float)(127 - (m & 127)) * lgk);
            }
            v4u o1, o2; o1.x = pk2(x1[0], x1[1]); o1.y = pk2(x1[2], x1[3]); o1.z = pk2(x1[4], x1[5]); o1.w = pk2(x1[6], x1[7]);
            o2.x = pk2(x2[0], x2[1]); o2.y = pk2(x2[2], x2[3]); o2.z = pk2(x2[4], x2[5]); o2.w = pk2(x2[6], x2[7]);
            *(v4u*)p = o1; *(v4u*)(p + 32) = o2;
        }
        if (jb >= 4) {
#pragma unroll
            for (int e = 0; e < 8; ++e) { T[(8 * c + e) * 72 + row] = (bf16)(pk2(x1[e] * wt, 0.f) & 0xffffu); T[(32 + 8 * c + e) * 72 + row] = (bf16)(pk2(x2[e] * wt, 0.f) & 0xffffu); }
        }
    }
    if (jb >= 4) {
        LDS_WAIT(); asm volatile("" ::: "memory");
#pragma unroll
        for (int it2 = 0; it2 < 8; ++it2) { const int dim = 8 * it2 + (F.lane >> 3), ch = F.lane & 7;
            const v4u v = *(const LAS v4u*)(T + dim * 72 + 8 * ch); *(v4u*)(dT + (size_t)dim * M + m0 + 8 * ch) = v; }
        LDS_WAIT(); asm volatile("" ::: "memory");
    }
}

__device__ __forceinline__ void lru_chunk_scan(Frame& F, const float* A, const float* U, float* carA, float* carH) {
    const int gid = blockIdx.x * (NWAVES * 64) + F.tid;
    if (gid >= BATCH * 256 * 256) return;
    const int ch = gid & 255, bc = gid >> 8; const size_t base = (size_t)bc * 64 * 256 + ch;
    float ap = 1.0f, hl = 0.f;
#pragma unroll 8
    for (int t = 0; t < 64; ++t) { const float a = A[base + (size_t)t * 256], u = U[base + (size_t)t * 256]; hl = a * hl + u; ap *= a; }
    carA[gid] = ap; carH[gid] = hl;
}
__device__ __forceinline__ void ret_state_unit(Frame& F, int unit, const bf16* rvT, const bf16* kwT, float* UT) {
    const int r = F.lane & 31, h2 = F.lane >> 5; const int h = unit & 3, bn = unit >> 2; const size_t m0 = (size_t)bn * 128;
    f32x16 acc[2][2];
#pragma unroll
    for (int i = 0; i < 2; ++i)
#pragma unroll
        for (int j = 0; j < 2; ++j) acc[i][j] = (f32x16){};
#pragma unroll
    for (int s = 0; s < 8; ++s) {
        bf16x8 af[2], bfr[2];
#pragma unroll
        for (int i = 0; i < 2; ++i) { af[i] = ld8(rvT + (size_t)(64 * h + 32 * i + r) * M + m0 + 16 * s + 8 * h2); bfr[i] = ld8(kwT + (size_t)(64 * h + 32 * i + r) * M + m0 + 16 * s + 8 * h2); }
#pragma unroll
        for (int et = 0; et < 2; ++et)
#pragma unroll
            for (int dt = 0; dt < 2; ++dt) acc[et][dt] = MFMA32(af[et], bfr[dt], acc[et][dt]);
    }
    float* dst = UT + (size_t)unit * 4096;
#pragma unroll
    for (int et = 0; et < 2; ++et)
#pragma unroll
        for (int dt = 0; dt < 2; ++dt)
#pragma unroll
            for (int reg = 0; reg < 16; ++reg) dst[(32 * et + crow(reg, h2)) * 64 + 32 * dt + r] = acc[et][dt][reg];
}

__device__ __forceinline__ void lru_carry_scan(Frame& F, const float* carA, const float* carH, float* carIn) {
    const int b = F.tid >> 8, ch = F.tid & 255; float hcar = 0.f;
#pragma unroll 8
    for (int c = 0; c < 256; ++c) { const size_t i = ((size_t)b * 256 + c) * 256 + ch; const float a = carA[i], hh = carH[i]; carIn[i] = hcar; hcar = a * hcar + hh; }
}
__device__ __forceinline__ void ret_state_scan(Frame& F, int gid, const float* UT, bf16* PREV) {
    const int b = gid >> 14, h = (gid >> 12) & 3, ed = gid & 4095;
    const float g128 = __builtin_amdgcn_exp2f(128.f * lg2gamma(h)); float st = 0.f;
#pragma unroll 8
    for (int n = 0; n < 128; ++n) { const size_t i = ((size_t)(b * 128 + n) * 4 + h) * 4096 + ed; const float u = UT[i]; PREV[i] = (bf16)(pk2(st, 0.f) & 0xffffu); st = g128 * st + u; }
}

__device__ __forceinline__ void fox_unit(Frame& F, int b, int h, int qt, const bf16* proj, const bf16* fvT, const float* c2, bf16* mix, int kt_min) {
    const int r = F.lane & 31, h2 = F.lane >> 5;
    const size_t mb = (size_t)b * SEQ; const int q0 = 32 * qt;
    const float* cc = c2 + ((size_t)b * 8 + h) * SEQ;
    bf16x8 qf[4];
#pragma unroll
    for (int s = 0; s < 4; ++s) qf[s] = ld8(proj + (mb + q0 + r) * NPROJ + C_FQ + 64 * h + 16 * s + 8 * h2);
    const float cq = cc[q0 + r];
    float mrow = -1e30f, lsum = 0.f;
    f32x16 o[2]; o[0] = (f32x16){}; o[1] = (f32x16){};
    for (int kt = qt; kt >= kt_min; --kt) {
        const int kb = 32 * kt;
        f32x16 sc = (f32x16){};
#pragma unroll
        for (int s = 0; s < 4; ++s) { const bf16x8 kf = ld8(proj + (mb + kb + swap23(r)) * NPROJ + C_FK + 64 * h + 16 * s + 8 * h2); sc = MFMA32(kf, qf[s], sc); }
        float ck[16];
#pragma unroll
        for (int g = 0; g < 4; ++g) { const f32x4 v = *(const f32x4*)(cc + kb + 16 * (g >> 1) + 8 * h2 + 4 * (g & 1)); ck[4 * g] = v[0]; ck[4 * g + 1] = v[1]; ck[4 * g + 2] = v[2]; ck[4 * g + 3] = v[3]; }
        float mx = -1e30f;
#pragma unroll
        for (int reg = 0; reg < 16; ++reg) { float x = sc[reg] + (cq - ck[reg]);
            if (kt == qt) { const int key = 16 * (reg >> 3) + 8 * h2 + (reg & 7); if (key > r) x = -1e30f; }
            sc[reg] = x; mx = fmaxf(mx, x); }
        mx = fmaxf(mx, __shfl_xor(mx, 32));
        const float mnew = fmaxf(mrow, mx);
        if (__any(mnew > mrow)) { const float al = __builtin_amdgcn_exp2f(mrow - mnew); lsum *= al;
#pragma unroll
            for (int reg = 0; reg < 16; ++reg) { o[0][reg] *= al; o[1][reg] *= al; }
            mrow = mnew; }
        float ps = 0.f;
#pragma unroll
        for (int reg = 0; reg < 16; ++reg) { const float p = __builtin_amdgcn_exp2f(sc[reg] - mrow); sc[reg] = p; ps += p; }
        lsum += ps;
        const bf16x8 p0 = pack8(sc, 0), p1 = pack8(sc, 1);
#pragma unroll
        for (int et = 0; et < 2; ++et) {
            const bf16* vp = fvT + (size_t)(64 * h + 32 * et + r) * M + mb + kb + 8 * h2;
            o[et] = MFMA32(ld8(vp), p0, o[et]); o[et] = MFMA32(ld8(vp + 16), p1, o[et]);
        }
    }
    lsum += __shfl_xor(lsum, 32);
    const float inv = 1.0f / lsum;
    bf16* op = mix + (mb + q0 + r) * D + 256 + 64 * h;
#pragma unroll
    for (int et = 0; et < 2; ++et)
#pragma unroll
        for (int g = 0; g < 4; ++g) { v2u w; w.x = pk2(o[et][4 * g] * inv, o[et][4 * g + 1] * inv); w.y = pk2(o[et][4 * g + 2] * inv, o[et][4 * g + 3] * inv);
            *(v2u*)(op + 32 * et + 8 * g + 4 * h2) = w; }
}

__device__ __forceinline__ float gelu_tanh(float x) { const float u = 0.7978845608028654f * (x + 0.044715f * x * x * x); const float t = 1.0f - 2.0f * __builtin_amdgcn_rcpf(1.0f + __builtin_amdgcn_exp2f(2.0f * LOG2E * u)); return 0.5f * x * (1.0f + t); }
__device__ __forceinline__ void lru_final(Frame& F, const float* A, const float* U, const float* carIn, const bf16* proj, bf16* mix) {
    const int gid = blockIdx.x * (NWAVES * 64) + F.tid;
    if (gid >= BATCH * 256 * 256) return;
    const int ch = gid & 255, bc = gid >> 8; const size_t m0 = (size_t)bc * 64;
    float hcur = carIn[gid];
#pragma unroll 8
    for (int t = 0; t < 64; ++t) { const size_t m = m0 + t; const float a = A[m * 256 + ch], u = U[m * 256 + ch]; hcur = a * hcur + u;
        const float y = bflo((unsigned)proj[m * NPROJ + C_LY + ch]); mix[m * D + ch] = (bf16)(pk2(hcur * gelu_tanh(y), 0.f) & 0xffffu); }
}
__device__ __forceinline__ void ret_final_unit(Frame& F, int unit, const bf16* proj, const bf16* rvT, const bf16* PREV, bf16* mix) {
    const int r = F.lane & 31, h2 = F.lane >> 5; const int h = unit & 3, bq = unit >> 2, qt = bq & 511, b = bq >> 9;
    const int n = qt >> 2, qi = qt & 3; const size_t mb = (size_t)b * SEQ, mc = mb + 128 * n, mq = mb + 32 * qt + r;
    const float lg = lg2gamma(h);
    bf16x8 qf[4];
#pragma unroll
    for (int s = 0; s < 4; ++s) qf[s] = ld8(proj + mq * NPROJ + C_RQ + 64 * h + 16 * s + 8 * h2);
    f32x16 y[2]; y[0] = (f32x16){}; y[1] = (f32x16){};
    for (int kt = 0; kt <= qi; ++kt) {
        const size_t kb = mc + 32 * kt;
        f32x16 sc = (f32x16){};
#pragma unroll
        for (int s = 0; s < 4; ++s) { const bf16x8 kf = ld8(proj + (kb + swap23(r)) * NPROJ + C_RK + 64 * h + 16 * s + 8 * h2); sc = MFMA32(kf, qf[s], sc); }
#pragma unroll
        for (int reg = 0; reg < 16; ++reg) { const int j = 32 * kt + 16 * (reg >> 3) + 8 * h2 + (reg & 7), i = 32 * qi + r, df = i - j;
            sc[reg] = df >= 0 ? sc[reg] * __builtin_amdgcn_exp2f((float)df * lg) : 0.f; }
        const bf16x8 p0 = pack8(sc, 0), p1 = pack8(sc, 1);
#pragma unroll
        for (int et = 0; et < 2; ++et) { const bf16* vp = rvT + (size_t)(64 * h + 32 * et + r) * M + kb + 8 * h2; y[et] = MFMA32(ld8(vp), p0, y[et]); y[et] = MFMA32(ld8(vp + 16), p1, y[et]); }
    }
    const bf16* st = PREV + ((size_t)(b * 128 + n) * 4 + h) * 4096;
    const float qw = __builtin_amdgcn_exp2f((float)(32 * qi + r + 1) * lg);
    float s1 = 0.f;
#pragma unroll
    for (int et = 0; et < 2; ++et) { f32x16 yc = (f32x16){};
#pragma unroll
        for (int s = 0; s < 4; ++s) yc = MFMA32(ld8(st + (32 * et + r) * 64 + 16 * s + 8 * h2), qf[s], yc);
#pragma unroll
        for (int reg = 0; reg < 16; ++reg) { y[et][reg] += qw * yc[reg]; s1 += y[et][reg]; } }
    s1 += __shfl_xor(s1, 32);
    const float mu = s1 * (1.0f / 64.0f); float s2 = 0.f;
#pragma unroll
    for (int et = 0; et < 2; ++et)
#pragma unroll
        for (int reg = 0; reg < 16; ++reg) { const float d = y[et][reg] - mu; s2 += d * d; }
    s2 += __shfl_xor(s2, 32);
    const float rs = 1.0f / sqrtf(s2 * (1.0f / 64.0f) + EPS);
    const bf16* gp = proj + mq * NPROJ + C_RG + 64 * h; bf16* op = mix + mq * D + 768 + 64 * h;
#pragma unroll
    for (int et = 0; et < 2; ++et)
#pragma unroll
        for (int g = 0; g < 4; ++g) { const int e = 32 * et + 8 * g + 4 * h2; const v2u gw = *(const v2u*)(gp + e);
            const float g0 = bflo(gw.x), g1 = bfhi(gw.x), g2 = bflo(gw.y), g3 = bfhi(gw.y);
            v2u w; w.x = pk2(g0 * sigmoidf_(g0) * (y[et][4 * g] - mu) * rs, g1 * sigmoidf_(g1) * (y[et][4 * g + 1] - mu) * rs);
            w.y = pk2(g2 * sigmoidf_(g2) * (y[et][4 * g + 2] - mu) * rs, g3 * sigmoidf_(g3) * (y[et][4 * g + 3] - mu) * rs);
            *(v2u*)(op + e) = w; }
}

__device__ __forceinline__ void cross_unit(Frame& F, int unit, const bf16* qc, const bf16* kmem  , const bf16* vtmem  , bf16* oc) {
    const int r = F.lane & 31, h2 = F.lane >> 5; const int hc = unit & 3, bq = unit >> 2, qt = bq & 511, b = bq >> 9;
    const size_t mq = (size_t)b * SEQ + 32 * qt + r;
    f32x16 sc[8];
#pragma unroll
    for (int kt = 0; kt < 8; ++kt) sc[kt] = (f32x16){};
#pragma unroll
    for (int sh = 0; sh < 2; ++sh) {
        bf16x8 qf[8];
#pragma unroll
        for (int s = 0; s < 8; ++s) qf[s] = ld8(qc + mq * D + 256 * hc + 128 * sh + 16 * s + 8 * h2);
#pragma unroll
        for (int kt = 0; kt < 8; ++kt) {
            const bf16* kp = kmem + (size_t)(b * 256 + 32 * kt + swap23(r)) * 2048 + 256 * hc + 128 * sh + 8 * h2;
#pragma unroll
            for (int s = 0; s < 8; ++s) sc[kt] = MFMA32(ld8(kp + 16 * s), qf[s], sc[kt]);
            __builtin_amdgcn_sched_barrier(0);
        }
    }
    float mx = -1e30f;
#pragma unroll
    for (int kt = 0; kt < 8; ++kt)
#pragma unroll
        for (int reg = 0; reg < 16; ++reg) mx = fmaxf(mx, sc[kt][reg]);
    mx = fmaxf(mx, __shfl_xor(mx, 32));
    float ls = 0.f; bf16x8 pf[8][2];
#pragma unroll
    for (int kt = 0; kt < 8; ++kt) {
#pragma unroll
        for (int reg = 0; reg < 16; ++reg) { const float p = __builtin_amdgcn_exp2f(sc[kt][reg] - mx); sc[kt][reg] = p; ls += p; }
        pf[kt][0] = pack8(sc[kt], 0); pf[kt][1] = pack8(sc[kt], 1); }
    ls += __shfl_xor(ls, 32);
    const float inv = 1.0f / ls;
    bf16* op = oc + mq * D + 256 * hc;
#pragma unroll
    for (int et = 0; et < 8; ++et) { f32x16 o = (f32x16){};
        const bf16* vp = vtmem + (size_t)(256 * hc + 32 * et + r) * 512 + b * 256 + 8 * h2;
#pragma unroll
        for (int kt = 0; kt < 8; ++kt) { o = MFMA32(ld8(vp + 32 * kt), pf[kt][0], o); o = MFMA32(ld8(vp + 32 * kt + 16), pf[kt][1], o); }
#pragma unroll
        for (int g = 0; g < 4; ++g) { v2u w; w.x = pk2(o[4 * g] * inv, o[4 * g + 1] * inv); w.y = pk2(o[4 * g + 2] * inv, o[4 * g + 3] * inv); *(v2u*)(op + 32 * et + 8 * g + 4 * h2) = w; } }
}


typedef const __attribute__((address_space(4))) Args* kargs_t;
#define KARGS() ({ kargs_t _p = (kargs_t)__builtin_amdgcn_kernarg_segment_ptr(); asm volatile("" : "+s"(_p)); _p; })
#define IN_F(i) ((const float*)ap->in[i])
#define x_in IN_F(0)
#define mem IN_F(1)
#define positions ((const int*)ap->in[2])
#define pre_mix_g IN_F(3)
#define post_mix_g IN_F(4)
#define w_in IN_F(5)
#define conv_w IN_F(6)
#define conv_b IN_F(7)
#define w_rg IN_F(8)
#define b_rg IN_F(9)
#define w_ig IN_F(10)
#define b_ig IN_F(11)
#define lru_lambda IN_F(12)
#define fox_b_f IN_F(13)
#define w_out IN_F(14)
#define pre_cross_g IN_F(15)
#define post_cross_g IN_F(16)
#define mem_norm_g IN_F(17)
#define w_cq IN_F(18)
#define w_ck IN_F(19)
#define w_cv IN_F(20)
#define w_co IN_F(21)
#define pre_ffn_g IN_F(22)
#define post_ffn_g IN_F(23)
#define w_gate IN_F(24)
#define w_up IN_F(25)
#define w_down IN_F(26)
#define xres (ap->out)
#define WSP(off) (ap->ws + (off))
#define WGT ((bf16*)WSP(WS_WGT))
#define LRUSP ((float*)WSP(WS_LRUSP))
#define MEMN ((bf16*)WSP(WS_MEMN))
#define LFT ((float*)WSP(WS_LFT))
#define C2 ((float*)WSP(WS_C2))
#define CARA ((float*)WSP(WS_CARA))
#define CARH ((float*)WSP(WS_CARH))
#define CARIN ((float*)WSP(WS_CARIN))
#define KMEM ((bf16*)WSP(WS_KMEM))
#define VTMEM ((bf16*)WSP(WS_VTMEM))
#define WCK ((bf16*)WSP(WS_WCK))
#define WCV ((bf16*)WSP(WS_WCV))
#define H ((bf16*)WSP(WS_H))
#define MIX ((bf16*)WSP(WS_H))
#define PROJ ((bf16*)WSP(WS_BIG))
#define QC ((bf16*)WSP(WS_BIG))
#define OC ((bf16*)WSP(WS_BIG + 64 * MiB))
#define HFF ((bf16*)WSP(WS_BIG))
#define AA ((float*)WSP(WS_AU))
#define UU ((float*)WSP(WS_AU + 32 * MiB))
#define RAW ((bf16*)WSP(WS_AU))
#define KWT ((bf16*)WSP(WS_KWT))
#define RVT ((bf16*)WSP(WS_RVT))
#define FVT ((bf16*)WSP(WS_FVT))
#define UT ((float*)WSP(WS_UT))
#define PREV ((bf16*)WSP(WS_PREV))
#define WL(off) ((const bf16*)WSP(WS_W + (size_t)l * W_LAYER + (off)))
extern __shared__ __attribute__((aligned(16))) unsigned char g_lds[];
__device__ __forceinline__ void frame_init(Frame& F) {
    int t = threadIdx.x; asm volatile("" : "+v"(t));
    F.lds = (LAS unsigned char*)g_lds;
    F.MISC = (volatile LAS unsigned*)(F.lds + MISC_OFF);
    F.tid = t; F.lane = t & 63; F.wave = __builtin_amdgcn_readfirstlane(t >> 6);
    F.G = gridDim.x; F.gw = blockIdx.x * NWAVES + F.wave; F.NGW = F.G * NWAVES;
}
#define GRID_BAR() xcd_barrier(bar)
#define PH_BEGIN { kargs_t ap = KARGS(); Frame F; frame_init(F);
#define PH_END }
template <int L> __device__ __forceinline__ void layer_fwd(const XcdBarrier& bar) {
    constexpr int l = L;
        if (blockIdx.x < 16) { PH_BEGIN cscan_job(F, LFT, C2, (int)blockIdx.x); PH_END }
        PH_BEGIN
            pg8::Gemm g{H, WL(W_IN), M, NPROJ, D}; pg8::StaticOrder S; S.init(M, NPROJ, F.G, (int)blockIdx.x);
            pg8::EpiPlain E{PROJ, NPROJ, C2FOX, 2, 4};
            pg8::gemm_phase<pg8::EpiPlain, pg8::StaticOrder, true, true>(F.lds + RING_OFF, g, S, E);
        PH_END
        GRID_BAR();
        PH_BEGIN
        for (int u = F.gw; u < 1024 + 512 * 20; u += F.NGW) {
            if (u < 1024) lru_gates_unit(F, u, PROJ, conv_w + (size_t)l * 4 * 256, conv_b + l * 256, WGT + (size_t)l * 2 * 4 * 64 * 64, b_rg + l * 256, b_ig + l * 256, LRUSP + l * 256, AA, UU);
            else { const int v = u - 1024; prep_unit(F, v / 20, v % 20, PROJ, positions, KWT, RVT, FVT); }
        }
        PH_END
        GRID_BAR();
        PH_BEGIN
        lru_chunk_scan(F, AA, UU, CARA, CARH);
        for (int u = F.gw; u < 1024; u += F.NGW) ret_state_unit(F, u, RVT, KWT, UT);
        PH_END
        GRID_BAR();
        PH_BEGIN
        if (blockIdx.x == 0) lru_carry_scan(F, CARA, CARH, CARIN);
        else if (blockIdx.x <= 64) ret_state_scan(F, ((int)blockIdx.x - 1) * (NWAVES * 64) + F.tid, UT, PREV);
        PH_END
        PH_BEGIN
            const int bh = F.gw >> 7, w = F.gw & 127;
            if (bh < 16) {
#pragma unroll 1
                for (int i = 0; i < 4; ++i) { const int qt = i == 0 ? 511 - w : i == 1 ? 383 - w : i == 2 ? 128 + w : w;
                    fox_unit(F, bh >> 3, bh & 7, qt, PROJ, FVT, C2, MIX, 0); }
            }
        PH_END
        GRID_BAR();
        PH_BEGIN
        lru_final(F, AA, UU, CARIN, PROJ, MIX);
#pragma unroll 1
        for (int i = 0; i < 2; ++i) { const int u0 = F.gw + i * F.NGW; if (u0 < 4096) { const int u = i == 0 ? u0 : ((((u0 >> 2)) ^ 3) << 2) | (u0 & 3); ret_final_unit(F, u, PROJ, RVT, PREV, MIX); } }
        PH_END
        GRID_BAR();
        PH_BEGIN
            pg8::Gemm g{MIX, WL(W_OUT), M, D, D}; pg8::StaticOrder S; S.init(M, D, F.G, (int)blockIdx.x);
            pg8::EpiPlain E{RAW, D, 1.f, 0, 0};
            pg8::gemm_phase<pg8::EpiPlain, pg8::StaticOrder, true, true>(F.lds + RING_OFF, g, S, E);
        PH_END
        GRID_BAR();
        PH_BEGIN
        thin_pass<true, true, false>(F, RAW, xres, xres, post_mix_g + l * D, pre_cross_g + l * D, H, nullptr, nullptr, nullptr);
        PH_END
        GRID_BAR();
        PH_BEGIN
            pg8::Gemm g{H, WL(W_CQ), M, D, D}; pg8::StaticOrder S; S.init(M, D, F.G, (int)blockIdx.x);
            pg8::EpiPlain E{QC, D, C2CROSS, 0, 4};
            pg8::gemm_phase<pg8::EpiPlain, pg8::StaticOrder, true, true>(F.lds + RING_OFF, g, S, E);
        PH_END
        GRID_BAR();
        PH_BEGIN
#pragma unroll 1
        for (int u = F.gw; u < 4096; u += F.NGW) cross_unit(F, u, QC, KMEM + (size_t)l * D, VTMEM + (size_t)l * D * (BATCH * MEML), OC);
        PH_END
        GRID_BAR();
        PH_BEGIN
            pg8::Gemm g{OC, WL(W_CO), M, D, D}; pg8::StaticOrder S; S.init(M, D, F.G, (int)blockIdx.x);
            pg8::EpiPlain E{RAW, D, 1.f, 0, 0};
            pg8::gemm_phase<pg8::EpiPlain, pg8::StaticOrder, true, true>(F.lds + RING_OFF, g, S, E);
        PH_END
        GRID_BAR();
        PH_BEGIN
        thin_pass<true, true, false>(F, RAW, xres, xres, post_cross_g + l * D, pre_ffn_g + l * D, H, nullptr, nullptr, nullptr);
        PH_END
        GRID_BAR();
        PH_BEGIN
            pg8::Gemm g{H, WL(W_GU), M, 2 * DFF, D}; pg8::StaticOrder S; S.init(M, 2 * DFF, F.G, (int)blockIdx.x);
            pg8::EpiSwiGLU E{HFF, DFF};
            pg8::gemm_phase<pg8::EpiSwiGLU, pg8::StaticOrder, true, true>(F.lds + RING_OFF, g, S, E);
        PH_END
        GRID_BAR();
        PH_BEGIN
            pg8::Gemm g{HFF, WL(W_DN), M, D, DFF}; pg8::StaticOrder S; S.init(M, D, F.G, (int)blockIdx.x);
            pg8::EpiPlain E{RAW, D, 1.f, 0, 0};
            pg8::gemm_phase<pg8::EpiPlain, pg8::StaticOrder, true, true>(F.lds + RING_OFF, g, S, E);
        PH_END
        GRID_BAR();
        if (l == 0) { PH_BEGIN thin_pass<true, true, true>(F, RAW, xres, xres, post_ffn_g + l * D, pre_mix_g + (l + 1) * D, H, w_in + (size_t)(l + 1) * D * INW, fox_b_f + (l + 1) * 8, LFT); PH_END GRID_BAR(); }
        else { PH_BEGIN thin_pass<true, false, false>(F, RAW, xres, xres, post_ffn_g + l * D, nullptr, nullptr, nullptr, nullptr, nullptr); PH_END }
}

__global__ void __launch_bounds__(NWAVES * 64, 2) hymba_fwd(Args args) {
    for (int u = threadIdx.x; u < (LDS_BYTES - LDSCTL_OFF) / 4; u += NWAVES * 64) ((LAS unsigned*)((LAS unsigned char*)g_lds + LDSCTL_OFF))[u] = 0u;
    __syncthreads();
    XcdBarrier bar = xcd_barrier_post((unsigned*)(args.ws + WS_CTL) + CW_BAR, (volatile LAS unsigned*)((LAS unsigned char*)g_lds + MISC_OFF) + 8);
    PH_BEGIN
        LAS float* scr = (LAS float*)(F.lds + RING_OFF + F.wave * 16384);
        constexpr int PER_LAYER = 16 * 96 + 3 * 16 * 32 + 2 * 16 * 88 + 44 * 32 + 2 * 16 * 32;
        for (int it = F.gw; it < 2 * PER_LAYER; it += F.NGW) {
            const int l = it / PER_LAYER; const int r = it % PER_LAYER; int o = 0;
            unsigned char* wl = WSP(WS_W + (size_t)l * W_LAYER);
            o = conv_matrix(F, scr, o, r, w_in + (size_t)l * D * INW, INW, D, 0, NPROJ, (bf16*)(wl + W_IN), 0, 1);
            o = conv_matrix(F, scr, o, r, w_out + (size_t)l * D * D, D, D, 0, D, (bf16*)(wl + W_OUT), 0, 0);
            o = conv_matrix(F, scr, o, r, w_cq + (size_t)l * D * D, D, D, 0, D, (bf16*)(wl + W_CQ), 0, 0);
            o = conv_matrix(F, scr, o, r, w_co + (size_t)l * D * D, D, D, 0, D, (bf16*)(wl + W_CO), 0, 0);
            o = conv_matrix(F, scr, o, r, w_gate + (size_t)l * D * DFF, DFF, D, 0, DFF, (bf16*)(wl + W_GU), 0, 2);
            o = conv_matrix(F, scr, o, r, w_up + (size_t)l * D * DFF, DFF, D, 0, DFF, (bf16*)(wl + W_GU), 0, 3);
            o = conv_matrix(F, scr, o, r, w_down + (size_t)l * DFF * D, D, DFF, 0, D, (bf16*)(wl + W_DN), 0, 0);
            o = conv_matrix(F, scr, o, r, w_ck + (size_t)l * D * D, D, D, 0, D, WCK + (size_t)l * D * D, 0, 0);
            o = conv_matrix(F, scr, o, r, w_cv + (size_t)l * D * D, D, D, 0, D, WCV + (size_t)l * D * D, 0, 0);
        }
        for (int e = blockIdx.x * (NWAVES * 64) + F.tid; e < 2 * 2 * 4 * 64 * 64; e += F.G * NWAVES * 64) {
            const int i = e & 63, j = (e >> 6) & 63, blk = (e >> 12) & 3, gate = (e >> 14) & 1, l = e >> 15;
            const float* src = gate ? w_ig : w_rg; WGT[e] = (bf16)(pk2(src[(((size_t)l * 4 + blk) * 64 + i) * 64 + j], 0.f) & 0xffffu);
        }
        if (blockIdx.x == 0) { const int e = F.tid; const float lam = lru_lambda[e]; LRUSP[e] = 8.0f * log1pf(expf(-lam)); }
        for (int row = F.gw; row < BATCH * MEML; row += F.NGW) {
            f32x4 v[4]; float ss = 0.f;
#pragma unroll
            for (int j = 0; j < 4; ++j) { v[j] = *(const f32x4*)(mem + (size_t)row * D + 4 * F.lane + 256 * j); ss += (v[j][0] * v[j][0] + v[j][1] * v[j][1]) + (v[j][2] * v[j][2] + v[j][3] * v[j][3]); }
            const float rstd = 1.0f / sqrtf(wave_sum(ss) * (1.0f / D) + EPS);
#pragma unroll
            for (int j = 0; j < 4; ++j) { const f32x4 g = *(const f32x4*)(mem_norm_g + 4 * F.lane + 256 * j); v2u w; w.x = pk2(v[j][0] * rstd * g[0], v[j][1] * rstd * g[1]); w.y = pk2(v[j][2] * rstd * g[2], v[j][3] * rstd * g[3]);
                *(v2u*)(MEMN + (size_t)row * D + 4 * F.lane + 256 * j) = w; }
        }
        __syncthreads();
    PH_END
    PH_BEGIN
        thin_pass<false, true, true>(F, nullptr, x_in, xres, nullptr, pre_mix_g, H, w_in, fox_b_f, LFT);
    PH_END
    GRID_BAR();
    PH_BEGIN
        pg8::Gemm g{MEMN, WCK, BATCH * MEML, 2 * D, D}; pg8::StaticOrder S; S.init(BATCH * MEML, 2 * D, F.G, (int)blockIdx.x);
        pg8::EpiPlain E{KMEM, 2 * D, 1.f, 0, 0};
        pg8::gemm_phase<pg8::EpiPlain, pg8::StaticOrder, true, true>(F.lds + RING_OFF, g, S, E);
    PH_END
    PH_BEGIN
        pg8::Gemm g{WCV, MEMN, 2 * D, BATCH * MEML, D}; pg8::StaticOrder S; S.init(2 * D, BATCH * MEML, F.G, (int)((blockIdx.x + F.G - 16) % F.G));
        pg8::EpiPlain E{VTMEM, BATCH * MEML, 1.f, 0, 0};
        pg8::gemm_phase<pg8::EpiPlain, pg8::StaticOrder, true, true>(F.lds + RING_OFF, g, S, E);
    PH_END

    layer_fwd<0>(bar);
    layer_fwd<1>(bar);
}

extern "C" void kernel_launch(void* const* d_in, const int* in_sizes, int n_in, void* d_out, int out_size, void* d_ws, size_t ws_size, hipStream_t stream) {
    static int grid = 0;
    if (grid == 0) {
        if (n_in != 27 || in_sizes[0] != M * D || out_size != M * D || ws_size < WS_END) { fprintf(stderr, "kernel_launch: unexpected shapes / workspace (n_in %d, ws %zu, need %zu); nothing launched\n", n_in, ws_size, (size_t)WS_END); grid = -1; return; }
        int dev = 0, cus = 0;
        if (hipGetDevice(&dev) != hipSuccess || hipDeviceGetAttribute(&cus, hipDeviceAttributeMultiprocessorCount, dev) != hipSuccess) { grid = -1; return; }
        if (hipFuncSetAttribute((const void*)hymba_fwd, hipFuncAttributeMaxDynamicSharedMemorySize, LDS_BYTES) != hipSuccess) { fprintf(stderr, "kernel_launch: hipFuncSetAttribute failed\n"); grid = -1; return; }
        (void)hipGetLastError();
        grid = cus < 256 ? cus : 256;
    }
    if (grid < 0) return;
    if (hipMemsetAsync((char*)d_ws + WS_CTL, 0, CTL_ZERO_BYTES, stream) != hipSuccess) return;
    Args a{};
    for (int i = 0; i < 27; ++i) a.in[i] = (const float*)d_in[i];
    a.out = (float*)d_out; a.ws = (unsigned char*)d_ws;
    hipLaunchKernelGGL(hymba_fwd, dim3(grid), dim3(NWAVES * 64), LDS_BYTES, stream, a);
}
```

```cpp
#include <hip/hip_runtime.h>
#include <cstdio>
#include <cstdint>
namespace pg8 {
#define PG8_LAS __attribute__((address_space(3)))
typedef unsigned short bf16_t;
typedef short bf16x8 __attribute__((ext_vector_type(8)));
typedef float f32x4 __attribute__((ext_vector_type(4)));
typedef unsigned u32x4 __attribute__((ext_vector_type(4)));
constexpr int BM = 256, BK = 64, HALF = 128, HTB = HALF * BK * 2  , STAGE_BYTES = 8 * HTB, NXCD = 8, WGM = 8;

__host__ __device__ __forceinline__ int lds_byte(int r, int c) { const int st = (r >> 4) * 2 + (c >> 5), rr = r & 15, cc = c & 31, ob = rr * 64 + cc * 2; return st * 1024 + (ob ^ (((ob >> 9) & 1) << 5)); }
__host__ __device__ __forceinline__ void stage_rc(int b, int& R, int& C) { const int st = b / 1024, sb = b % 1024, swz = sb ^ (((sb >> 9) & 1) << 5); R = (st >> 1) * 16 + swz / 64; C = (st & 1) * 32 + (swz % 64) / 2; }
__host__ __device__ __forceinline__ int perm32(int rho) { const int n = rho >> 4, i = rho & 15; return 8 * (i >> 2) + 4 * n + (i & 3); }

struct Unit { int pm, pn; };
struct Gemm { const bf16_t* A; const bf16_t* Bt; int M, N, K; };

struct StaticOrder {
    int nM, nN, nwg, G, c;
    __host__ __device__ void init(int M, int N, int G_, int c_) { nM = M / BM; nN = N / BM; nwg = nM * nN; G = G_; c = c_; }
    __host__ __device__ bool next(int i, Unit& u) const {
        const long L = (long)i * G + c; if (L >= nwg) return false;
        int wgid = (int)L; { const int q = nwg / NXCD, r = nwg % NXCD, xcd = wgid % NXCD, off = wgid / NXCD; wgid = (xcd < r ? xcd * (q + 1) : r * (q + 1) + (xcd - r) * q) + off; }
        const int nig = WGM * nN, gid = wgid / nig, fm = gid * WGM, gsz = (nM - fm) < WGM ? (nM - fm) : WGM;
        u.pm = fm + ((wgid % nig) % gsz); u.pn = (wgid % nig) / gsz; return true;
    }
    __device__ __forceinline__ void a_ready(const Unit&) const {}
    __device__ __forceinline__ void done(const Unit&) const {}
};


typedef float f32x2 __attribute__((ext_vector_type(2)));
typedef __bf16 bf16x2_t __attribute__((ext_vector_type(2)));
__device__ __forceinline__ unsigned cvt_pk_bf16(float lo, float hi) { f32x2 v = {lo, hi}; bf16x2_t b = __builtin_convertvector(v, bf16x2_t); return __builtin_bit_cast(unsigned, b); }

struct EpiPlain {
    static constexpr bool PERM = true, AFTER_DRAIN = false;
    bf16_t* O; int ldc; float sc; int sc_lo, sc_hi;
    __device__ __forceinline__ void operator()(const f32x4 (&acc)[2][2][4][2], const Unit& u, int wr, int wc, int fr, int fq) const {
        const int row0 = u.pm * BM + wr * 64 + fr; const int col0 = u.pn * BM + wc * 32 + 8 * fq;
        const float s = (u.pn >= sc_lo && u.pn < sc_hi) ? sc : 1.f;
#pragma unroll
        for (int ai = 0; ai < 2; ++ai)
#pragma unroll
            for (int m = 0; m < 4; ++m) { bf16_t* rowp = O + (size_t)(row0 + ai * HALF + m * 16) * ldc + col0;
#pragma unroll
                for (int bj = 0; bj < 2; ++bj) { const f32x4 v0 = acc[ai][bj][m][0] * s, v1 = acc[ai][bj][m][1] * s;
                    u32x4 w; w.x = cvt_pk_bf16(v0[0], v0[1]); w.y = cvt_pk_bf16(v0[2], v0[3]); w.z = cvt_pk_bf16(v1[0], v1[1]); w.w = cvt_pk_bf16(v1[2], v1[3]);
                    *(u32x4*)(rowp + bj * HALF) = w; } }
    }
};
struct EpiSwiGLU {
    static constexpr bool PERM = true, AFTER_DRAIN = false;
    bf16_t* O; int ldc;
    __device__ __forceinline__ void operator()(const f32x4 (&acc)[2][2][4][2], const Unit& u, int wr, int wc, int fr, int fq) const {
        const int row0 = u.pm * BM + wr * 64 + fr; const int col0 = u.pn * HALF + wc * 32 + 8 * fq;
#pragma unroll
        for (int ai = 0; ai < 2; ++ai)
#pragma unroll
            for (int m = 0; m < 4; ++m) { bf16_t* rowp = O + (size_t)(row0 + ai * HALF + m * 16) * ldc + col0;
                float o[8];
#pragma unroll
                for (int n = 0; n < 2; ++n)
#pragma unroll
                    for (int i = 0; i < 4; ++i) { const float g = acc[ai][0][m][n][i], up = acc[ai][1][m][n][i];
                        const float sg = g * __builtin_amdgcn_rcpf(1.0f + __builtin_amdgcn_exp2f(-1.4426950408889634f * g)); o[4 * n + i] = sg * up; }
                u32x4 w; w.x = cvt_pk_bf16(o[0], o[1]); w.y = cvt_pk_bf16(o[2], o[3]); w.z = cvt_pk_bf16(o[4], o[5]); w.w = cvt_pk_bf16(o[6], o[7]);
                *(u32x4*)rowp = w; }
    }
};

template <class Epi, class Sched, bool ALIGN_EPI = false, bool SP2 = false>
__device__ __forceinline__ void gemm_phase(PG8_LAS unsigned char* lds, const Gemm g, const Sched& S, const Epi& E) {
    int tid_ = threadIdx.x; asm volatile("" : "+v"(tid_));
    const int tid = tid_, wid = __builtin_amdgcn_readfirstlane(tid >> 6), lane = tid & 63, wr = wid >> 2, wc = wid & 3, fr = lane & 15, fq = lane >> 4;
    const int K = g.K, nt = K / BK;
    unsigned voffA[2], voffB[2];
#pragma unroll
    for (int i = 0; i < 2; ++i) { int R, C; stage_rc(tid * 16 + i * 8192, R, C); const int Rb = Epi::PERM ? ((R & ~31) + perm32(R & 31)) : R;
        voffA[i] = (unsigned)(R * K + C) * 2u; voffB[i] = (unsigned)(Rb * K + C) * 2u; }
    const size_t kstep = (size_t)(BK * 2);
    const size_t hstep = (size_t)HALF * K * 2;
    const size_t tstep = 2 * hstep;
    const unsigned ldsw = (unsigned)wid * 1024u;
    const int aoff = lds_byte(wr * 64 + fr, fq * 8), boff = lds_byte(wc * 32 + fr, fq * 8);
#define PG8_SA(b, h) (((b) * 2 + (h)) * HTB)
#define PG8_SB(b, h) ((4 + (b) * 2 + (h)) * HTB)
#define PG8_STAGE(bufoff, gbase, voff) do { _Pragma("unroll") for (int _i = 0; _i < 2; ++_i) \
        __builtin_amdgcn_global_load_lds((const unsigned*)((const char*)(gbase) + (voff)[_i]), (PG8_LAS unsigned*)(lds + (bufoff) + ldsw + _i * 8192), 16, 0, 0); } while (0)
#define PG8_LDA(dst, b, h) do { _Pragma("unroll") for (int m = 0; m < 4; ++m) _Pragma("unroll") for (int k = 0; k < 2; ++k) dst[m][k] = *(const PG8_LAS bf16x8*)(lds + PG8_SA(b, h) + aoff + m * 2048 + k * 1024); } while (0)
#define PG8_LDB(dst, b, h) do { _Pragma("unroll") for (int n = 0; n < 2; ++n) _Pragma("unroll") for (int k = 0; k < 2; ++k) dst[n][k] = *(const PG8_LAS bf16x8*)(lds + PG8_SB(b, h) + boff + n * 2048 + k * 1024); } while (0)
#define PG8_MMA(ai, bj, At, Bt) do { __builtin_amdgcn_s_setprio(1); _Pragma("unroll") for (int m = 0; m < 4; ++m) _Pragma("unroll") for (int n = 0; n < 2; ++n) _Pragma("unroll") for (int k = 0; k < 2; ++k) \
        acc[ai][bj][m][n] = __builtin_amdgcn_mfma_f32_16x16x32_bf16(Bt[n][k], At[m][k], acc[ai][bj][m][n], 0, 0, 0); __builtin_amdgcn_s_setprio(0); } while (0)
#define PG8_WAIT_V(n) asm volatile("s_waitcnt vmcnt(" #n ")" ::: "memory")
#define PG8_WAIT_L(n) asm volatile("s_waitcnt lgkmcnt(" #n ")" ::: "memory")
#define PG8_BAR __builtin_amdgcn_s_barrier()
#define PG8_SCHED __builtin_amdgcn_sched_barrier(0)
    Unit cur, nxt; int ui = 0;
    if (!S.next(0, cur)) return;
    f32x4 acc[2][2][4][2];
#pragma unroll
    for (int a = 0; a < 2; ++a)
#pragma unroll
        for (int b = 0; b < 2; ++b)
#pragma unroll
            for (int m = 0; m < 4; ++m)
#pragma unroll
                for (int n = 0; n < 2; ++n) acc[a][b][m][n] = (f32x4){0.f, 0.f, 0.f, 0.f};
    bf16x8 At[4][2], B0[2][2], B1[2][2];
    const char* cA = (const char*)g.A + (size_t)cur.pm * tstep; const char* cB = (const char*)g.Bt + (size_t)cur.pn * tstep;
    S.a_ready(cur);
    if constexpr (SP2) {
        PG8_STAGE(PG8_SB(0, 0), cB, voffB); PG8_STAGE(PG8_SB(0, 1), cB + hstep, voffB); PG8_STAGE(PG8_SA(0, 0), cA, voffA); PG8_STAGE(PG8_SA(0, 1), cA + hstep, voffA);
        if (wr == 1) PG8_BAR;
        PG8_WAIT_V(2); PG8_BAR;
        PG8_STAGE(PG8_SB(1, 0), cB + kstep, voffB); PG8_STAGE(PG8_SA(1, 0), cA + kstep, voffA); PG8_STAGE(PG8_SB(1, 1), cB + hstep + kstep, voffB);
        PG8_WAIT_V(6); PG8_BAR;
    } else {
        PG8_STAGE(PG8_SB(0, 0), cB, voffB); PG8_STAGE(PG8_SA(0, 0), cA, voffA); PG8_STAGE(PG8_SB(0, 1), cB + hstep, voffB); PG8_STAGE(PG8_SA(0, 1), cA + hstep, voffA);
        if (wr == 1) PG8_BAR;
        PG8_WAIT_V(4); PG8_BAR;
        PG8_STAGE(PG8_SB(1, 0), cB + kstep, voffB); PG8_STAGE(PG8_SA(1, 0), cA + kstep, voffA); PG8_STAGE(PG8_SB(1, 1), cB + hstep + kstep, voffB);
        PG8_WAIT_V(6); PG8_BAR;
    }
    for (;;) {
        const bool has_next = S.next(ui + 1, nxt);
        const char* nA = has_next ? (const char*)g.A + (size_t)nxt.pm * tstep : cA; const char* nB = has_next ? (const char*)g.Bt + (size_t)nxt.pn * tstep : cB;
        for (int t = 0; t < nt; t += 2) {
            const bool last = (t == nt - 2);
            const char* a1 = cA + (size_t)(t + 1) * kstep;
            const char* a2 = last ? nA : cA + (size_t)(t + 2) * kstep; const char* b2 = last ? nB : cB + (size_t)(t + 2) * kstep;
            const char* a3 = a2 + kstep; const char* b3 = b2 + kstep;
            if (last && has_next) S.a_ready(nxt);
            if constexpr (SP2) {
            PG8_LDB(B0, 0, 0); PG8_LDB(B1, 0, 1); PG8_SCHED; PG8_LDA(At, 0, 0); PG8_STAGE(PG8_SA(1, 1), a1 + hstep, voffA);
            PG8_WAIT_V(8); PG8_WAIT_L(0); PG8_BAR; PG8_MMA(0, 0, At, B0); PG8_MMA(0, 1, At, B1); PG8_BAR; PG8_SCHED;
            PG8_LDA(At, 0, 1); PG8_STAGE(PG8_SB(0, 0), b2, voffB); PG8_STAGE(PG8_SB(0, 1), b2 + hstep, voffB); PG8_STAGE(PG8_SA(0, 0), a2, voffA);
            PG8_WAIT_V(8); PG8_WAIT_L(0); PG8_BAR; PG8_MMA(1, 0, At, B0); PG8_MMA(1, 1, At, B1); PG8_BAR; PG8_SCHED;
            PG8_LDB(B0, 1, 0); PG8_LDB(B1, 1, 1); PG8_SCHED; PG8_LDA(At, 1, 0); PG8_STAGE(PG8_SA(0, 1), a2 + hstep, voffA);
            PG8_WAIT_V(8); PG8_WAIT_L(0); PG8_BAR; PG8_MMA(0, 0, At, B0); PG8_MMA(0, 1, At, B1); PG8_BAR; PG8_SCHED;
            PG8_LDA(At, 1, 1); PG8_STAGE(PG8_SB(1, 0), b3, voffB); PG8_STAGE(PG8_SB(1, 1), b3 + hstep, voffB); PG8_STAGE(PG8_SA(1, 0), a3, voffA);
            PG8_WAIT_V(8); PG8_WAIT_L(0); PG8_BAR; PG8_MMA(1, 0, At, B0); PG8_MMA(1, 1, At, B1); PG8_BAR; PG8_SCHED;
            } else {
            PG8_LDB(B0, 0, 0); PG8_SCHED; PG8_LDA(At, 0, 0); PG8_STAGE(PG8_SA(1, 1), a1 + hstep, voffA);
            PG8_WAIT_L(8); PG8_BAR; PG8_WAIT_L(0); PG8_MMA(0, 0, At, B0); PG8_BAR; PG8_SCHED;
            PG8_LDB(B1, 0, 1); PG8_STAGE(PG8_SB(0, 0), b2, voffB);
            PG8_BAR; PG8_WAIT_L(0); PG8_MMA(0, 1, At, B1); PG8_BAR;
            PG8_LDA(At, 0, 1); PG8_STAGE(PG8_SA(0, 0), a2, voffA);
            PG8_BAR; PG8_WAIT_L(0); PG8_MMA(1, 0, At, B0); PG8_BAR; PG8_SCHED;
            PG8_STAGE(PG8_SB(0, 1), b2 + hstep, voffB);
            PG8_WAIT_V(6); PG8_BAR; PG8_MMA(1, 1, At, B1); PG8_BAR;
            PG8_LDB(B0, 1, 0); PG8_SCHED; PG8_LDA(At, 1, 0); PG8_STAGE(PG8_SA(0, 1), a2 + hstep, voffA);
            PG8_WAIT_L(8); PG8_BAR; PG8_WAIT_L(0); PG8_MMA(0, 0, At, B0); PG8_BAR; PG8_SCHED;
            PG8_LDB(B1, 1, 1); PG8_STAGE(PG8_SB(1, 0), b3, voffB);
            PG8_BAR; PG8_WAIT_L(0); PG8_MMA(0, 1, At, B1); PG8_BAR;
            PG8_LDA(At, 1, 1); PG8_STAGE(PG8_SA(1, 0), a3, voffA);
            PG8_BAR; PG8_WAIT_L(0); PG8_MMA(1, 0, At, B0); PG8_BAR; PG8_SCHED;
            PG8_STAGE(PG8_SB(1, 1), b3 + hstep, voffB);
            PG8_WAIT_V(6); PG8_BAR; PG8_MMA(1, 1, At, B1); PG8_BAR;
            }
        }
        if constexpr (ALIGN_EPI) { if (wr == 0) PG8_BAR; }
        if constexpr (!Epi::AFTER_DRAIN) { E(acc, cur, wr, wc, fr, fq); S.done(cur); }
        if (!has_next) break;
#pragma unroll
        for (int a = 0; a < 2; ++a)
#pragma unroll
            for (int b = 0; b < 2; ++b)
#pragma unroll
                for (int m = 0; m < 4; ++m)
#pragma unroll
                    for (int n = 0; n < 2; ++n) acc[a][b][m][n] = (f32x4){0.f, 0.f, 0.f, 0.f};
        cur = nxt; cA = nA; cB = nB; ++ui;
        if constexpr (ALIGN_EPI) { if (wr == 1) PG8_BAR; }
    }
    PG8_WAIT_V(0);
    if constexpr (!ALIGN_EPI) { if (wr == 0) PG8_BAR; }
    PG8_BAR;
    if constexpr (Epi::AFTER_DRAIN) { E.fused(acc, cur, wr, wc, fr, fq, lds, wid, lane); S.done(cur); }
#undef PG8_SA
#undef PG8_SB
#undef PG8_STAGE
#undef PG8_LDA
#undef PG8_LDB
#undef PG8_MMA
#undef PG8_WAIT_V
#undef PG8_WAIT_L
#undef PG8_BAR
#undef PG8_SCHED
}
}

constexpr int NWAVES = 8;
constexpr int BATCH = 2, SEQ = 16384, M = BATCH * SEQ, D = 1024, NPROJ = 3072, INW = 3080, DFF = 2816, MEML = 256;
constexpr int C_LX = 0, C_LY = 256, C_FQ = 512, C_FK = 1024, C_FV = 1536, C_RQ = 2048, C_RK = 2304, C_RV = 2560, C_RG = 2816;
constexpr float EPS = 1e-6f;
constexpr float LOG2E = 1.4426950408889634f;
constexpr float C2FOX = 0.125f * 1.4426950408889634f;
constexpr float C2CROSS = 0.0625f * 1.4426950408889634f;
#ifndef FOX_PRUNE
#define FOX_PRUNE 0
#endif

constexpr size_t MiB = 1u << 20, KiB = 1u << 10;
constexpr size_t WS_CTL = 0, CTL_ZERO_BYTES = 1 * MiB;
constexpr size_t WS_WGT = 1 * MiB;
constexpr size_t WS_LRUSP = WS_WGT + 128 * KiB;
constexpr size_t WS_FOXMAX = WS_LRUSP + 4 * KiB;
constexpr size_t WS_MEMN = 2 * MiB;
constexpr size_t WS_LFT = 3 * MiB;
constexpr size_t WS_C2 = 4 * MiB;
constexpr size_t WS_CARA = 5 * MiB, WS_CARH = WS_CARA + 512 * KiB, WS_CARIN = 6 * MiB;
constexpr size_t WS_KMEM = 7 * MiB;
constexpr size_t WS_VTMEM = 9 * MiB;
constexpr size_t WS_W = 12 * MiB;
constexpr size_t W_IN = 0, W_OUT = W_IN + (size_t)NPROJ * D * 2, W_CQ = W_OUT + (size_t)D * D * 2, W_CO = W_CQ + (size_t)D * D * 2,
                 W_GU = W_CO + (size_t)D * D * 2, W_DN = W_GU + (size_t)2 * DFF * D * 2, W_LAYER = W_DN + (size_t)D * DFF * 2;
constexpr size_t WS_WCK = WS_W + 2 * W_LAYER, WS_WCV = WS_WCK + (size_t)2 * D * D * 2, WS_WEND = WS_WCV + (size_t)2 * D * D * 2;
constexpr size_t WS_H = 77 * MiB;
constexpr size_t WS_BIG = 141 * MiB;
constexpr size_t WS_AU = 333 * MiB;
constexpr size_t WS_KWT = 397 * MiB, WS_RVT = 413 * MiB, WS_FVT = 429 * MiB;
constexpr size_t WS_UT = 461 * MiB, WS_PREV = 477 * MiB, WS_END = 485 * MiB;
static_assert(WS_WEND <= WS_H && WS_H + (size_t)M * D * 2 <= WS_BIG && WS_BIG + (size_t)M * NPROJ * 2 <= WS_AU && WS_AU + (size_t)M * 256 * 8 <= WS_KWT, "ws map");
constexpr int CW_BAR = 4096;
constexpr int CW_FOXK = 8192;
constexpr float FOX_T2 = 45.0f;

constexpr int RING_OFF = 0, RING_BYTES = 131072;
constexpr int LDSCTL_OFF = RING_BYTES, MISC_OFF = LDSCTL_OFF + 320;
constexpr int LDS_BYTES = 147456;

#define GAS __attribute__((address_space(1)))
#define LAS __attribute__((address_space(3)))
typedef unsigned short bf16;
typedef unsigned v4u __attribute__((ext_vector_type(4)));
typedef unsigned v2u __attribute__((ext_vector_type(2)));
typedef float f32x4 __attribute__((ext_vector_type(4)));
typedef float f32x16 __attribute__((ext_vector_type(16)));
typedef short bf16x8 __attribute__((ext_vector_type(8)));
typedef GAS unsigned gu32;
#define RLX_AGENT __ATOMIC_RELAXED, __HIP_MEMORY_SCOPE_AGENT
#define LDS_WAIT() asm volatile("s_waitcnt lgkmcnt(0)" ::: "memory")
#define VM_WAIT() asm volatile("s_waitcnt vmcnt(0)" ::: "memory")
#define MFMA32(a, b, c) __builtin_amdgcn_mfma_f32_32x32x16_bf16((a), (b), (c), 0, 0, 0)
__device__ __forceinline__ unsigned pk2(float lo, float hi) { return pg8::cvt_pk_bf16(lo, hi); }
__device__ __forceinline__ float bflo(unsigned w) { return __uint_as_float(w << 16); }
__device__ __forceinline__ float bfhi(unsigned w) { return __uint_as_float(w & 0xffff0000u); }
__device__ __forceinline__ int crow(int r, int hi) { return (r & 3) + 8 * (r >> 2) + 4 * hi; }
__device__ __forceinline__ int swap23(int r) { return (r & 0x13) | ((r & 4) << 1) | ((r & 8) >> 1); }
__device__ __forceinline__ bf16x8 ld8(const bf16* p) { return *(const bf16x8*)p; }
__device__ __forceinline__ bf16x8 pack8(const f32x16& x, int s) {
    v4u p; p.x = pk2(x[8 * s], x[8 * s + 1]); p.y = pk2(x[8 * s + 2], x[8 * s + 3]); p.z = pk2(x[8 * s + 4], x[8 * s + 5]); p.w = pk2(x[8 * s + 6], x[8 * s + 7]);
    return __builtin_bit_cast(bf16x8, p); }
__device__ __forceinline__ float wave_sum(float v) {
#pragma unroll
    for (int o = 1; o < 64; o <<= 1) v += __shfl_xor(v, o);
    return v;
}
__device__ __forceinline__ float sigmoidf_(float x) { return __builtin_amdgcn_rcpf(1.0f + __builtin_amdgcn_exp2f(-LOG2E * x)); }
__device__ __forceinline__ float lg2gamma(int h) { return h == 0 ? -0.04580368961312479f : h == 1 ? -0.02272007650008353f : h == 2 ? -0.011315313227834146f : -0.005646563141142063f; }

#define XB_TMO      128
#define XB_XCNT(j)  (256  + 64 * (j))
#define XB_XSUB(j)  (1280 + 64 * (j))
#define XB_XGEN(j)  (2304 + 64 * (j))
#define XB_TOP      3328
#define XB_TOPGEN   3392
#define XCD_BAR_WORDS 3456
#define XB_SPIN_CAP (1u << 18)

__device__ __forceinline__ unsigned xb_ld(unsigned* p)              { return __hip_atomic_load(p, __ATOMIC_RELAXED, __HIP_MEMORY_SCOPE_AGENT); }
__device__ __forceinline__ unsigned xb_add(unsigned* p, unsigned v) { return __hip_atomic_fetch_add(p, v, __ATOMIC_RELAXED, __HIP_MEMORY_SCOPE_AGENT); }
__device__ __forceinline__ unsigned xb_xcc_id() { return (unsigned)__builtin_amdgcn_s_getreg((3 << 11) | 20) & 0xFu; }
#define XB_SPIN(cond, bar) do { unsigned _sp = 0; while (cond) { __builtin_amdgcn_s_sleep(1); \
    if ((++_sp & 255u) == 0u) { if (xb_ld(&(bar)[XB_TMO])) break; if (_sp > XB_SPIN_CAP) { atomicAdd(&(bar)[XB_TMO], 1u); break; } } } } while (0)

struct XcdBarrier {
    unsigned* bar; unsigned x;
    volatile LAS unsigned* st;
};

__device__ __forceinline__ XcdBarrier xcd_barrier_post(unsigned* bar, volatile LAS unsigned* st) {
    XcdBarrier b; b.bar = bar; b.x = xb_xcc_id(); b.st = st;
    if (threadIdx.x == 0) (void)xb_add(&bar[XB_XCNT(b.x)], 1u);
    return b;
}
__device__ __forceinline__ void xcd_barrier_complete(unsigned* bar, unsigned x, unsigned& nloc, unsigned& nx) {
    const unsigned G = gridDim.x * gridDim.y * gridDim.z;
    unsigned sum, cnt, mine, sp = 0u;
    for (;;) {
        sum = 0u; cnt = 0u; mine = 0u;
#pragma unroll
        for (unsigned j = 0; j < 16; ++j) { const unsigned c = xb_ld(&bar[XB_XCNT(j)]); sum += c; cnt += (c > 0u) ? 1u : 0u; mine = (j == x) ? c : mine; }
        if (sum == G) break;
        __builtin_amdgcn_s_sleep(1);
        if ((++sp & 255u) == 0u) { if (xb_ld(&bar[XB_TMO])) break; if (sp > XB_SPIN_CAP) { atomicAdd(&bar[XB_TMO], 1u); break; } }
    }
    nloc = mine > 0u ? mine : 1u; nx = cnt > 0u ? cnt : 1u;
}

__device__ __forceinline__ void xcd_barrier(const XcdBarrier& b) {
    asm volatile("s_waitcnt vmcnt(0)" ::: "memory");
    __syncthreads();
    if (threadIdx.x == 0) {
        unsigned* bar = b.bar;
        __builtin_amdgcn_s_waitcnt(0);
        unsigned nloc = b.st[0], nx = b.st[1];
        if (nloc == 0u) { xcd_barrier_complete(bar, b.x, nloc, nx); b.st[0] = nloc; b.st[1] = nx; }
        const unsigned old = xb_add(&bar[XB_XSUB(b.x)], 1u);
        const unsigned gen = old / nloc;
        if (old + 1u == (gen + 1u) * nloc) {
            __builtin_amdgcn_fence(__ATOMIC_RELEASE, "agent");
            asm volatile("s_waitcnt vmcnt(0)" ::: "memory");
            const unsigned og = xb_add(&bar[XB_TOP], 1u);
            const unsigned tg = og / nx;
            if (og + 1u == (tg + 1u) * nx) xb_add(&bar[XB_TOPGEN], 1u);
            else XB_SPIN(xb_ld(&bar[XB_TOPGEN]) == tg, bar);
            __builtin_amdgcn_fence(__ATOMIC_ACQUIRE, "agent");
            xb_add(&bar[XB_XGEN(b.x)], 1u);
            asm volatile("s_waitcnt vmcnt(0)" ::: "memory");
        } else {
            XB_SPIN(xb_ld(&bar[XB_XGEN(b.x)]) == gen, bar);
            __builtin_amdgcn_fence(__ATOMIC_ACQUIRE, "agent");
            asm volatile("s_waitcnt vmcnt(0)" ::: "memory");
        }
    }
    __syncthreads();
}

struct Args { const float* in[27]; float* out; unsigned char* ws; };
struct Frame {
    LAS unsigned char* lds;
    volatile LAS unsigned* MISC;
    gu32* ctl;
    int tid, lane, wave;
    int G, gw, NGW;
    unsigned char* ws;
};

__device__ __forceinline__ void transpose_item(const float* W, int ldw, int k0, int n0, bf16* WT, int K, int dn0, LAS float* scr, int lane) {
#pragma unroll 8
    for (int i = 0; i < 32; ++i) { const int kk = 2 * i + (lane >> 5); scr[kk * 33 + (lane & 31)] = W[(size_t)(k0 + kk) * ldw + n0 + (lane & 31)]; }
    LDS_WAIT(); asm volatile("" ::: "memory");
    const int c = lane & 7;
#pragma unroll
    for (int j = 0; j < 4; ++j) { const int n = (lane >> 3) + 8 * j; const LAS float* s = scr + (8 * c) * 33 + n;
        v4u o; o.x = pk2(s[0 * 33], s[1 * 33]); o.y = pk2(s[2 * 33], s[3 * 33]); o.z = pk2(s[4 * 33], s[5 * 33]); o.w = pk2(s[6 * 33], s[7 * 33]);
        *(GAS v4u*)(WT + (size_t)(dn0 + n) * K + k0 + 8 * c) = o; }
    LDS_WAIT(); asm volatile("" ::: "memory");
}
__device__ __forceinline__ int conv_matrix(Frame& F, LAS float* scr, int it0, int it, const float* W, int ldw, int K, int csrc0, int ncols, bf16* WT, int drow0, int mode) {
    const int nblk = ncols / 32, nitems = (K / 64) * nblk;
    const int r = it - it0;
    if (r >= 0 && r < nitems) {
        const int kb = r / nblk, nb = r % nblk; int n0 = csrc0 + 32 * nb, dn0;
        if (mode == 0) dn0 = drow0 + 32 * nb;
        else if (mode == 1) { dn0 = 32 * nb; if (dn0 >= 2048) n0 += 8; }
        else { const int j = 32 * nb; dn0 = 256 * (j / 128) + 128 * (mode - 2) + (j % 128); }
        transpose_item(W, ldw, 64 * kb, n0, WT, K, dn0, scr, F.lane);
    }
    return it0 + nitems;
}

template <bool HAS_RAW, bool HAS_H, bool HAS_FF>
__device__ __forceinline__ void thin_pass(Frame& F, const bf16* raw, const float* xin, float* xout, const float* gpost, const float* gpre, bf16* hout,
                                          const float* win_l  , const float* bfox, float* lfT) {
    LAS float* wfT = (LAS float*)(F.lds + RING_OFF);
    if (HAS_FF) {
        for (int k = F.tid; k < D; k += NWAVES * 64) { const f32x4 a = *(const f32x4*)(win_l + (size_t)k * INW + 2048), b = *(const f32x4*)(win_l + (size_t)k * INW + 2052);
            wfT[0 * D + k] = a[0]; wfT[1 * D + k] = a[1]; wfT[2 * D + k] = a[2]; wfT[3 * D + k] = a[3]; wfT[4 * D + k] = b[0]; wfT[5 * D + k] = b[1]; wfT[6 * D + k] = b[2]; wfT[7 * D + k] = b[3]; }
        __syncthreads();
    }
    f32x4 gp[4], gq[4];
#pragma unroll
    for (int j = 0; j < 4; ++j) { gp[j] = HAS_RAW ? *(const f32x4*)(gpost + 4 * F.lane + 256 * j) : (f32x4){0.f, 0.f, 0.f, 0.f}; gq[j] = HAS_H ? *(const f32x4*)(gpre + 4 * F.lane + 256 * j) : (f32x4){0.f, 0.f, 0.f, 0.f}; }
    for (int row = F.gw; row < M; row += F.NGW) {
        f32x4 x[4];
#pragma unroll
        for (int j = 0; j < 4; ++j) x[j] = *(const f32x4*)(xin + (size_t)row * D + 4 * F.lane + 256 * j);
        if (HAS_RAW) {
            f32x4 rw[4]; float ss = 0.f;
#pragma unroll
            for (int j = 0; j < 4; ++j) { const v2u w = *(const v2u*)(raw + (size_t)row * D + 4 * F.lane + 256 * j); rw[j] = (f32x4){bflo(w.x), bfhi(w.x), bflo(w.y), bfhi(w.y)};
                ss += (rw[j][0] * rw[j][0] + rw[j][1] * rw[j][1]) + (rw[j][2] * rw[j][2] + rw[j][3] * rw[j][3]); }
            const float rstd = 1.0f / sqrtf(wave_sum(ss) * (1.0f / D) + EPS);
#pragma unroll
            for (int j = 0; j < 4; ++j) x[j] = x[j] + rw[j] * rstd * gp[j];
        }
#pragma unroll
        for (int j = 0; j < 4; ++j) *(f32x4*)(xout + (size_t)row * D + 4 * F.lane + 256 * j) = x[j];
        if (HAS_H) {
            float ss = 0.f;
#pragma unroll
            for (int j = 0; j < 4; ++j) ss += (x[j][0] * x[j][0] + x[j][1] * x[j][1]) + (x[j][2] * x[j][2] + x[j][3] * x[j][3]);
            const float rstd = 1.0f / sqrtf(wave_sum(ss) * (1.0f / D) + EPS);
#pragma unroll
            for (int j = 0; j < 4; ++j) { x[j] = x[j] * rstd * gq[j]; v2u w; w.x = pk2(x[j][0], x[j][1]); w.y = pk2(x[j][2], x[j][3]); *(v2u*)(hout + (size_t)row * D + 4 * F.lane + 256 * j) = w; }
            if (HAS_FF) {
                float ff[8];
#pragma unroll
                for (int q = 0; q < 8; ++q) { float a = 0.f;
#pragma unroll
                    for (int j = 0; j < 4; ++j) { const f32x4 w = *(const LAS f32x4*)(wfT + q * D + 4 * F.lane + 256 * j); a += (x[j][0] * w[0] + x[j][1] * w[1]) + (x[j][2] * w[2] + x[j][3] * w[3]); }
                    ff[q] = wave_sum(a); }
                float mine = 0.f;
#pragma unroll
                for (int q = 0; q < 8; ++q) if (F.lane == q) mine = ff[q];
                if (F.lane < 8) { const float z = mine + bfox[F.lane]; const float lf = fminf(z, 0.f) - log1pf(expf(-fabsf(z)));
                    const int b = row / SEQ, t = row % SEQ; lfT[((size_t)b * 8 + F.lane) * SEQ + t] = lf; }
            }
        }
    }
}

__device__ __forceinline__ void cscan_job(Frame& F, const float* lfT, float* c2, int bh) {
    LAS double* tot = (LAS double*)(F.lds + RING_OFF);
    const float* src = lfT + (size_t)bh * SEQ + 32 * F.tid; float* dst = c2 + (size_t)bh * SEQ + 32 * F.tid;
    float v[32];
#pragma unroll
    for (int j = 0; j < 8; ++j) { const f32x4 a = *(const f32x4*)(src + 4 * j); v[4 * j] = a[0]; v[4 * j + 1] = a[1]; v[4 * j + 2] = a[2]; v[4 * j + 3] = a[3]; }
#pragma unroll
    for (int j = 1; j < 32; ++j) v[j] += v[j - 1];
    double incl = (double)v[31];
#pragma unroll
    for (int o = 1; o < 64; o <<= 1) { const double t = __shfl_up(incl, o); if (F.lane >= o) incl += t; }
    if (F.lane == 63) tot[F.wave] = incl;
    __syncthreads();
    double off = incl - (double)v[31];
    for (int w = 0; w < F.wave; ++w) off += tot[w];
#pragma unroll
    for (int j = 0; j < 8; ++j) { f32x4 o; o[0] = (float)((off + (double)v[4 * j]) * 1.4426950408889634); o[1] = (float)((off + (double)v[4 * j + 1]) * 1.4426950408889634);
        o[2] = (float)((off + (double)v[4 * j + 2]) * 1.4426950408889634); o[3] = (float)((off + (double)v[4 * j + 3]) * 1.4426950408889634); *(f32x4*)(dst + 4 * j) = o; }
    __syncthreads();
}

__device__ __forceinline__ void lru_gates_unit(Frame& F, int unit, const bf16* proj, const float* convw, const float* convb, const bf16* wgt  ,
                                               const float* brg, const float* big, const float* sp, float* Aout, float* Uout) {
    const int r = F.lane & 31, h2 = F.lane >> 5;
    const int m = unit * 32 + r, tl = m % SEQ;
    for (int blk = 0; blk < 4; ++blk) {
        bf16x8 xcf[4];
#pragma unroll
        for (int s = 0; s < 4; ++s) {
            const int cb = 64 * blk + 16 * s + 8 * h2;
            float xc[8];
            { const f32x4 b0 = *(const f32x4*)(convb + cb), b1 = *(const f32x4*)(convb + cb + 4); xc[0] = b0[0]; xc[1] = b0[1]; xc[2] = b0[2]; xc[3] = b0[3]; xc[4] = b1[0]; xc[5] = b1[1]; xc[6] = b1[2]; xc[7] = b1[3]; }
#pragma unroll
            for (int k = 0; k < 4; ++k) {
                if (tl - 3 + k >= 0) {
                    const v4u w = *(const v4u*)(proj + (size_t)(m - 3 + k) * NPROJ + C_LX + cb);
                    const f32x4 c0 = *(const f32x4*)(convw + k * 256 + cb), c1 = *(const f32x4*)(convw + k * 256 + cb + 4);
                    xc[0] += c0[0] * bflo(w.x); xc[1] += c0[1] * bfhi(w.x); xc[2] += c0[2] * bflo(w.y); xc[3] += c0[3] * bfhi(w.y);
                    xc[4] += c1[0] * bflo(w.z); xc[5] += c1[1] * bfhi(w.z); xc[6] += c1[2] * bflo(w.w); xc[7] += c1[3] * bfhi(w.w);
                }
            }
            v4u p; p.x = pk2(xc[0], xc[1]); p.y = pk2(xc[2], xc[3]); p.z = pk2(xc[4], xc[5]); p.w = pk2(xc[6], xc[7]);
            xcf[s] = __builtin_bit_cast(bf16x8, p);
        }
        f32x16 Gr[2], Gi[2];
#pragma unroll
        for (int jt = 0; jt < 2; ++jt) { Gr[jt] = (f32x16){}; Gi[jt] = (f32x16){}; }
#pragma unroll
        for (int jt = 0; jt < 2; ++jt)
#pragma unroll
            for (int s = 0; s < 4; ++s) {
                const bf16x8 wr_ = ld8(wgt + ((size_t)(0 * 4 + blk) * 64 + 32 * jt + r) * 64 + 16 * s + 8 * h2);
                const bf16x8 wi_ = ld8(wgt + ((size_t)(1 * 4 + blk) * 64 + 32 * jt + r) * 64 + 16 * s + 8 * h2);
                Gr[jt] = MFMA32(wr_, xcf[s], Gr[jt]); Gi[jt] = MFMA32(wi_, xcf[s], Gi[jt]);
            }
#pragma unroll
        for (int jt = 0; jt < 2; ++jt)
#pragma unroll
            for (int g = 0; g < 4; ++g) {
                const int ch = 64 * blk + 32 * jt + 8 * g + 4 * h2;
                f32x4 xc = *(const f32x4*)(convb + ch);
#pragma unroll
                for (int k = 0; k < 4; ++k) {
                    if (tl - 3 + k >= 0) {
                        const v2u w = *(const v2u*)(proj + (size_t)(m - 3 + k) * NPROJ + C_LX + ch);
                        const f32x4 c0 = *(const f32x4*)(convw + k * 256 + ch);
                        xc[0] += c0[0] * bflo(w.x); xc[1] += c0[1] * bfhi(w.x); xc[2] += c0[2] * bflo(w.y); xc[3] += c0[3] * bfhi(w.y);
                    }
                }
                const f32x4 br = *(const f32x4*)(brg + ch), bi = *(const f32x4*)(big + ch), s8 = *(const f32x4*)(sp + ch);
                f32x4 av, uv;
#pragma unroll
                for (int i = 0; i < 4; ++i) {
                    const float rg = sigmoidf_(Gr[jt][4 * g + i] + br[i]), ig = sigmoidf_(Gi[jt][4 * g + i] + bi[i]);
                    const float la = -rg * s8[i]; const float a = __builtin_amdgcn_exp2f(LOG2E * la);
                    av[i] = a; uv[i] = sqrtf(fmaxf(fmaf(-a, a, 1.0f), 0.f)) * (ig * xc[i]);
                }
                *(f32x4*)(Aout + (size_t)m * 256 + ch) = av; *(f32x4*)(Uout + (size_t)m * 256 + ch) = uv;
            }
    }
}

__device__ __forceinline__ float invfreq(int c, int e) {
    const float t[32] = {1.0f, 0.7498942017555237f, 0.5623413324356079f, 0.4216965138912201f, 0.3162277638912201f, 0.23713737726211548f, 0.17782793939113617f, 0.1333521455526352f,
        0.10000000149011612f, 0.0749894231557846f, 0.05623413249850273f, 0.04216964915394783f, 0.03162277489900589f, 0.023713737726211548f, 0.017782794311642647f, 0.013335213996469975f,
        0.009999999776482582f, 0.007498942315578461f, 0.005623413249850273f, 0.0042169648222625256f, 0.003162277629598975f, 0.0023713738191872835f, 0.0017782794311642647f, 0.0013335214462131262f,
        0.0010000000474974513f, 0.0007498941849917173f, 0.000562341301701963f, 0.0004216965171508491f, 0.0003162277571391314f, 0.00023713737027719617f, 0.00017782794020604342f, 0.0001333521504420787f};
    return c == 0 ? t[e] : c == 1 ? t[8 + e] : c == 2 ? t[16 + e] : t[24 + e];
}
__device__ __forceinline__ void prep_unit(Frame& F, int tt, int jb, bf16* proj, const int* positions, bf16* kwT, bf16* rvT, bf16* fvT) {
    LAS bf16* T = (LAS bf16*)(F.lds + RING_OFF + F.wave * 9216);
    const int m0 = 64 * tt, rr = F.lane >> 2, c = F.lane & 3;
    int scol, h; bf16* dT = nullptr;
    if (jb < 4) { h = jb; scol = C_RQ + 64 * h; }
    else if (jb < 8) { h = jb - 4; scol = C_RK + 64 * h; dT = kwT + (size_t)(64 * h) * M; }
    else if (jb < 12) { h = jb - 8; scol = C_RV + 64 * h; dT = rvT + (size_t)(64 * h) * M; }
    else { h = jb - 12; scol = C_FV + 64 * h; dT = fvT + (size_t)(64 * h) * M; }
    const bool rot = jb < 8, isk = (jb >= 4 && jb < 8);
    const float lgk = lg2gamma(h);
#pragma unroll
    for (int it = 0; it < 4; ++it) {
        const int row = 16 * it + rr, m = m0 + row;
        bf16* p = proj + (size_t)m * NPROJ + scol + 8 * c;
        const v4u w1 = *(const v4u*)p, w2 = *(const v4u*)(p + 32);
        float x1[8] = {bflo(w1.x), bfhi(w1.x), bflo(w1.y), bfhi(w1.y), bflo(w1.z), bfhi(w1.z), bflo(w1.w), bfhi(w1.w)};
        float x2[8] = {bflo(w2.x), bfhi(w2.x), bflo(w2.y), bfhi(w2.y), bflo(w2.z), bfhi(w2.z), bflo(w2.w), bfhi(w2.w)};
        float wt = 1.0f;
        if (rot) {
            const float pos = (float)positions[m];
#pragma unroll
            for (int e = 0; e < 8; ++e) {
                const float ang = pos * invfreq(c, e);
                const double rev = (double)ang * 0.15915494309189535; const float fr = (float)(rev - __builtin_rint(rev));
                const float sn = __builtin_amdgcn_sinf(fr), cs = __builtin_amdgcn_cosf(fr);
                const float a = x1[e], b = x2[e]; x1[e] = a * cs - b * sn; x2[e] = a * sn + b * cs;
            }
            if (isk) {
#pragma unroll
                for (int e = 0; e < 8; ++e) { x1[e] *= 0.125f; x2[e] *= 0.125f; }
                wt = __builtin_amdgcn_exp2f((float)(127 - (m & 127)) * lgk);
            }
            v4u o1, o2; o1.x = pk2(x1[0], x1[1]); o1.y = pk2(x1[2], x1[3]); o1.z = pk2(x1[4], x1[5]); o1.w = pk2(x1[6], x1[7]);
            o2.x = pk2(x2[0], x2[1]); o2.y = pk2(x2[2], x2[3]); o2.z = pk2(x2[4], x2[5]); o2.w = pk2(x2[6], x2[7]);
            *(v4u*)p = o1; *(v4u*)(p + 32) = o2;
        }
        if (jb >= 4) {
#pragma unroll
            for (int e = 0; e < 8; ++e) { T[(8 * c + e) * 72 + row] = (bf16)(pk2(x1[e] * wt, 0.f) & 0xffffu); T[(32 + 8 * c + e) * 72 + row] = (bf16)(pk2(x2[e] * wt, 0.f) & 0xffffu); }
        }
    }
    if (jb >= 4) {
        LDS_WAIT(); asm volatile("" ::: "memory");
#pragma unroll
        for (int it2 = 0; it2 < 8; ++it2) { const int dim = 8 * it2 + (F.lane >> 3), ch = F.lane & 7;
            const v4u v = *(const LAS v4u*)(T + dim * 72 + 8 * ch); *(v4u*)(dT + (size_t)dim * M + m0 + 8 * ch) = v; }
        LDS_WAIT(); asm volatile("" ::: "memory");
    }
}


__device__ __forceinline__ void fox_knorm_unit(Frame& F, int tt, int h, const bf16* proj, unsigned* kmax  ) {
    const int m0 = 64 * tt, rr = F.lane >> 2, c = F.lane & 3; float mx = 0.f;
#pragma unroll
    for (int it = 0; it < 4; ++it) {
        const bf16* p = proj + (size_t)(m0 + 16 * it + rr) * NPROJ + C_FK + 64 * h + 8 * c;
        const v4u w1 = *(const v4u*)p, w2 = *(const v4u*)(p + 32);
        float s = 0.f;
        s += bflo(w1.x) * bflo(w1.x) + bfhi(w1.x) * bfhi(w1.x) + bflo(w1.y) * bflo(w1.y) + bfhi(w1.y) * bfhi(w1.y) + bflo(w1.z) * bflo(w1.z) + bfhi(w1.z) * bfhi(w1.z) + bflo(w1.w) * bflo(w1.w) + bfhi(w1.w) * bfhi(w1.w);
        s += bflo(w2.x) * bflo(w2.x) + bfhi(w2.x) * bfhi(w2.x) + bflo(w2.y) * bflo(w2.y) + bfhi(w2.y) * bfhi(w2.y) + bflo(w2.z) * bflo(w2.z) + bfhi(w2.z) * bfhi(w2.z) + bflo(w2.w) * bflo(w2.w) + bfhi(w2.w) * bfhi(w2.w);
        s += __shfl_xor(s, 1); s += __shfl_xor(s, 2);
        mx = fmaxf(mx, s);
    }
#pragma unroll
    for (int o = 4; o < 64; o <<= 1) mx = fmaxf(mx, __shfl_xor(mx, o));
    if (F.lane == 0) atomicMax(kmax + ((m0 / SEQ) * 8 + h), __float_as_uint(mx * 1.0001f));
}

__device__ __forceinline__ void lru_chunk_scan(Frame& F, const float* A, const float* U, float* carA, float* carH) {
    const int gid = blockIdx.x * (NWAVES * 64) + F.tid;
    if (gid >= BATCH * 256 * 256) return;
    const int ch = gid & 255, bc = gid >> 8; const size_t base = (size_t)bc * 64 * 256 + ch;
    float ap = 1.0f, hl = 0.f;
#pragma unroll 8
    for (int t = 0; t < 64; ++t) { const float a = A[base + (size_t)t * 256], u = U[base + (size_t)t * 256]; hl = a * hl + u; ap *= a; }
    carA[gid] = ap; carH[gid] = hl;
}
__device__ __forceinline__ void ret_state_unit(Frame& F, int unit, const bf16* rvT, const bf16* kwT, float* UT) {
    const int r = F.lane & 31, h2 = F.lane >> 5; const int h = unit & 3, bn = unit >> 2; const size_t m0 = (size_t)bn * 128;
    f32x16 acc[2][2];
#pragma unroll
    for (int i = 0; i < 2; ++i)
#pragma unroll
        for (int j = 0; j < 2; ++j) acc[i][j] = (f32x16){};
#pragma unroll
    for (int s = 0; s < 8; ++s) {
        bf16x8 af[2], bfr[2];
#pragma unroll
        for (int i = 0; i < 2; ++i) { af[i] = ld8(rvT + (size_t)(64 * h + 32 * i + r) * M + m0 + 16 * s + 8 * h2); bfr[i] = ld8(kwT + (size_t)(64 * h + 32 * i + r) * M + m0 + 16 * s + 8 * h2); }
#pragma unroll
        for (int et = 0; et < 2; ++et)
#pragma unroll
            for (int dt = 0; dt < 2; ++dt) acc[et][dt] = MFMA32(af[et], bfr[dt], acc[et][dt]);
    }
    float* dst = UT + (size_t)unit * 4096;
#pragma unroll
    for (int et = 0; et < 2; ++et)
#pragma unroll
        for (int dt = 0; dt < 2; ++dt)
#pragma unroll
            for (int reg = 0; reg < 16; ++reg) dst[(32 * et + crow(reg, h2)) * 64 + 32 * dt + r] = acc[et][dt][reg];
}

__device__ __forceinline__ void lru_carry_scan(Frame& F, const float* carA, const float* carH, float* carIn) {
    const int b = F.tid >> 8, ch = F.tid & 255; float hcar = 0.f;
#pragma unroll 8
    for (int c = 0; c < 256; ++c) { const size_t i = ((size_t)b * 256 + c) * 256 + ch; const float a = carA[i], hh = carH[i]; carIn[i] = hcar; hcar = a * hcar + hh; }
}
__device__ __forceinline__ void ret_state_scan(Frame& F, int gid, const float* UT, bf16* PREV) {
    const int b = gid >> 14, h = (gid >> 12) & 3, ed = gid & 4095;
    const float g128 = __builtin_amdgcn_exp2f(128.f * lg2gamma(h)); float st = 0.f;
#pragma unroll 8
    for (int n = 0; n < 128; ++n) { const size_t i = ((size_t)(b * 128 + n) * 4 + h) * 4096 + ed; const float u = UT[i]; PREV[i] = (bf16)(pk2(st, 0.f) & 0xffffu); st = g128 * st + u; }
}

__device__ __forceinline__ void fox_unit(Frame& F, int b, int h, int qt, const bf16* proj, const bf16* fvT, const float* c2, bf16* mix, const unsigned* kmax) {
    const int r = F.lane & 31, h2 = F.lane >> 5;
    const size_t mb = (size_t)b * SEQ; const int q0 = 32 * qt;
    const float* cc = c2 + ((size_t)b * 8 + h) * SEQ;
    bf16x8 qf[4];
#pragma unroll
    for (int s = 0; s < 4; ++s) qf[s] = ld8(proj + (mb + q0 + r) * NPROJ + C_FQ + 64 * h + 16 * s + 8 * h2);
    const float cq = cc[q0 + r];
    float qn = 0.f;
#pragma unroll
    for (int s = 0; s < 4; ++s) { const v4u w = __builtin_bit_cast(v4u, qf[s]);
        qn += bflo(w.x) * bflo(w.x) + bfhi(w.x) * bfhi(w.x) + bflo(w.y) * bflo(w.y) + bfhi(w.y) * bfhi(w.y) + bflo(w.z) * bflo(w.z) + bfhi(w.z) * bfhi(w.z) + bflo(w.w) * bflo(w.w) + bfhi(w.w) * bfhi(w.w); }
    qn += __shfl_xor(qn, 32);
#pragma unroll
    for (int o_ = 1; o_ < 32; o_ <<= 1) qn = fmaxf(qn, __shfl_xor(qn, o_));
    const float smax = sqrtf(qn * 1.0001f) * sqrtf(__uint_as_float(kmax[b * 8 + h])) * 1.0001f;
    const float cq0 = cc[q0];
    float thr = -3.0e38f;
    float mrow = -1e30f, lsum = 0.f;
    f32x16 o[2]; o[0] = (f32x16){}; o[1] = (f32x16){};
    for (int kt = qt; kt >= 0; --kt) {
        const int kb = 32 * kt;
        if (kt < qt) { if (smax + cq0 - cc[kb + 31] < thr) break; }
        f32x16 sc = (f32x16){};
#pragma unroll
        for (int s = 0; s < 4; ++s) { const bf16x8 kf = ld8(proj + (mb + kb + swap23(r)) * NPROJ + C_FK + 64 * h + 16 * s + 8 * h2); sc = MFMA32(kf, qf[s], sc); }
        float ck[16];
#pragma unroll
        for (int g = 0; g < 4; ++g) { const f32x4 v = *(const f32x4*)(cc + kb + 16 * (g >> 1) + 8 * h2 + 4 * (g & 1)); ck[4 * g] = v[0]; ck[4 * g + 1] = v[1]; ck[4 * g + 2] = v[2]; ck[4 * g + 3] = v[3]; }
        float mx = -1e30f;
#pragma unroll
        for (int reg = 0; reg < 16; ++reg) { float x = sc[reg] + (cq - ck[reg]);
            if (kt == qt) { const int key = 16 * (reg >> 3) + 8 * h2 + (reg & 7); if (key > r) x = -1e30f; }
            sc[reg] = x; mx = fmaxf(mx, x); }
        mx = fmaxf(mx, __shfl_xor(mx, 32));
        const float mnew = fmaxf(mrow, mx);
        if (__any(mnew > mrow)) { const float al = __builtin_amdgcn_exp2f(mrow - mnew); lsum *= al;
#pragma unroll
            for (int reg = 0; reg < 16; ++reg) { o[0][reg] *= al; o[1][reg] *= al; }
            mrow = mnew; }
        float ps = 0.f;
#pragma unroll
        for (int reg = 0; reg < 16; ++reg) { const float p = __builtin_amdgcn_exp2f(sc[reg] - mrow); sc[reg] = p; ps += p; }
        lsum += ps;
        if (kt == qt) { float mm = mrow;
#pragma unroll
            for (int o_ = 1; o_ < 32; o_ <<= 1) mm = fminf(mm, __shfl_xor(mm, o_));
            thr = mm - FOX_T2; }
        const bf16x8 p0 = pack8(sc, 0), p1 = pack8(sc, 1);
#pragma unroll
        for (int et = 0; et < 2; ++et) {
            const bf16* vp = fvT + (size_t)(64 * h + 32 * et + r) * M + mb + kb + 8 * h2;
            o[et] = MFMA32(ld8(vp), p0, o[et]); o[et] = MFMA32(ld8(vp + 16), p1, o[et]);
        }
    }
    lsum += __shfl_xor(lsum, 32);
    const float inv = 1.0f / lsum;
    bf16* op = mix + (mb + q0 + r) * D + 256 + 64 * h;
#pragma unroll
    for (int et = 0; et < 2; ++et)
#pragma unroll
        for (int g = 0; g < 4; ++g) { v2u w; w.x = pk2(o[et][4 * g] * inv, o[et][4 * g + 1] * inv); w.y = pk2(o[et][4 * g + 2] * inv, o[et][4 * g + 3] * inv);
            *(v2u*)(op + 32 * et + 8 * g + 4 * h2) = w; }
}

__device__ __forceinline__ float gelu_tanh(float x) { const float u = 0.7978845608028654f * (x + 0.044715f * x * x * x); const float t = 1.0f - 2.0f * __builtin_amdgcn_rcpf(1.0f + __builtin_amdgcn_exp2f(2.0f * LOG2E * u)); return 0.5f * x * (1.0f + t); }
__device__ __forceinline__ void lru_final(Frame& F, const float* A, const float* U, const float* carIn, const bf16* proj, bf16* mix) {
    const int gid = blockIdx.x * (NWAVES * 64) + F.tid;
    if (gid >= BATCH * 256 * 256) return;
    const int ch = gid & 255, bc = gid >> 8; const size_t m0 = (size_t)bc * 64;
    float hcur = carIn[gid];
#pragma unroll 8
    for (int t = 0; t < 64; ++t) { const size_t m = m0 + t; const float a = A[m * 256 + ch], u = U[m * 256 + ch]; hcur = a * hcur + u;
        const float y = bflo((unsigned)proj[m * NPROJ + C_LY + ch]); mix[m * D + ch] = (bf16)(pk2(hcur * gelu_tanh(y), 0.f) & 0xffffu); }
}
__device__ __forceinline__ void ret_final_unit(Frame& F, int unit, const bf16* proj, const bf16* rvT, const bf16* PREV, bf16* mix) {
    const int r = F.lane & 31, h2 = F.lane >> 5; const int h = unit & 3, bq = unit >> 2, qt = bq & 511, b = bq >> 9;
    const int n = qt >> 2, qi = qt & 3; const size_t mb = (size_t)b * SEQ, mc = mb + 128 * n, mq = mb + 32 * qt + r;
    const float lg = lg2gamma(h);
    bf16x8 qf[4];
#pragma unroll
    for (int s = 0; s < 4; ++s) qf[s] = ld8(proj + mq * NPROJ + C_RQ + 64 * h + 16 * s + 8 * h2);
    f32x16 y[2]; y[0] = (f32x16){}; y[1] = (f32x16){};
    for (int kt = 0; kt <= qi; ++kt) {
        const size_t kb = mc + 32 * kt;
        f32x16 sc = (f32x16){};
#pragma unroll
        for (int s = 0; s < 4; ++s) { const bf16x8 kf = ld8(proj + (kb + swap23(r)) * NPROJ + C_RK + 64 * h + 16 * s + 8 * h2); sc = MFMA32(kf, qf[s], sc); }
#pragma unroll
        for (int reg = 0; reg < 16; ++reg) { const int j = 32 * kt + 16 * (reg >> 3) + 8 * h2 + (reg & 7), i = 32 * qi + r, df = i - j;
            sc[reg] = df >= 0 ? sc[reg] * __builtin_amdgcn_exp2f((float)df * lg) : 0.f; }
        const bf16x8 p0 = pack8(sc, 0), p1 = pack8(sc, 1);
#pragma unroll
        for (int et = 0; et < 2; ++et) { const bf16* vp = rvT + (size_t)(64 * h + 32 * et + r) * M + kb + 8 * h2; y[et] = MFMA32(ld8(vp), p0, y[et]); y[et] = MFMA32(ld8(vp + 16), p1, y[et]); }
    }
    const bf16* st = PREV + ((size_t)(b * 128 + n) * 4 + h) * 4096;
    const float qw = __builtin_amdgcn_exp2f((float)(32 * qi + r + 1) * lg);
    float s1 = 0.f;
#pragma unroll
    for (int et = 0; et < 2; ++et) { f32x16 yc = (f32x16){};
#pragma unroll
        for (int s = 0; s < 4; ++s) yc = MFMA32(ld8(st + (32 * et + r) * 64 + 16 * s + 8 * h2), qf[s], yc);
#pragma unroll
        for (int reg = 0; reg < 16; ++reg) { y[et][reg] += qw * yc[reg]; s1 += y[et][reg]; } }
    s1 += __shfl_xor(s1, 32);
    const float mu = s1 * (1.0f / 64.0f); float s2 = 0.f;
#pragma unroll
    for (int et = 0; et < 2; ++et)
#pragma unroll
        for (int reg = 0; reg < 16; ++reg) { const float d = y[et][reg] - mu; s2 += d * d; }
    s2 += __shfl_xor(s2, 32);
    const float rs = 1.0f / sqrtf(s2 * (1.0f / 64.0f) + EPS);
    const bf16* gp = proj + mq * NPROJ + C_RG + 64 * h; bf16* op = mix + mq * D + 768 + 64 * h;
#pragma unroll
    for (int et = 0; et < 2; ++et)
#pragma unroll
        for (int g = 0; g < 4; ++g) { const int e = 32 * et + 8 * g + 4 * h2; const v2u gw = *(const v2u*)(gp + e);
            const float g0 = bflo(gw.x), g1 = bfhi(gw.x), g2 = bflo(gw.y), g3 = bfhi(gw.y);
            v2u w; w.x = pk2(g0 * sigmoidf_(g0) * (y[et][4 * g] - mu) * rs, g1 * sigmoidf_(g1) * (y[et][4 * g + 1] - mu) * rs);
            w.y = pk2(g2 * sigmoidf_(g2) * (y[et][4 * g + 2] - mu) * rs, g3 * sigmoidf_(g3) * (y[et][4 * g + 3] - mu) * rs);
            *(v2u*)(op + e) = w; }
}

__device__ __forceinline__ void cross_unit(Frame& F, int unit, const bf16* qc, const bf16* kmem  , const bf16* vtmem  , bf16* oc) {
    const int r = F.lane & 31, h2 = F.lane >> 5; const int hc = unit & 3, bq = unit >> 2, qt = bq & 511, b = bq >> 9;
    const size_t mq = (size_t)b * SEQ + 32 * qt + r;
    f32x16 sc[8];
#pragma unroll
    for (int kt = 0; kt < 8; ++kt) sc[kt] = (f32x16){};
#pragma unroll
    for (int sh = 0; sh < 2; ++sh) {
        bf16x8 qf[8];
#pragma unroll
        for (int s = 0; s < 8; ++s) qf[s] = ld8(qc + mq * D + 256 * hc + 128 * sh + 16 * s + 8 * h2);
#pragma unroll
        for (int kt = 0; kt < 8; ++kt) {
            const bf16* kp = kmem + (size_t)(b * 256 + 32 * kt + swap23(r)) * 2048 + 256 * hc + 128 * sh + 8 * h2;
#pragma unroll
            for (int s = 0; s < 8; ++s) sc[kt] = MFMA32(ld8(kp + 16 * s), qf[s], sc[kt]);
            __builtin_amdgcn_sched_barrier(0);
        }
    }
    float mx = -1e30f;
#pragma unroll
    for (int kt = 0; kt < 8; ++kt)
#pragma unroll
        for (int reg = 0; reg < 16; ++reg) mx = fmaxf(mx, sc[kt][reg]);
    mx = fmaxf(mx, __shfl_xor(mx, 32));
    float ls = 0.f; bf16x8 pf[8][2];
#pragma unroll
    for (int kt = 0; kt < 8; ++kt) {
#pragma unroll
        for (int reg = 0; reg < 16; ++reg) { const float p = __builtin_amdgcn_exp2f(sc[kt][reg] - mx); sc[kt][reg] = p; ls += p; }
        pf[kt][0] = pack8(sc[kt], 0); pf[kt][1] = pack8(sc[kt], 1); }
    ls += __shfl_xor(ls, 32);
    const float inv = 1.0f / ls;
    bf16* op = oc + mq * D + 256 * hc;
#pragma unroll
    for (int et = 0; et < 8; ++et) { f32x16 o = (f32x16){};
        const bf16* vp = vtmem + (size_t)(256 * hc + 32 * et + r) * 512 + b * 256 + 8 * h2;
#pragma unroll
        for (int kt = 0; kt < 8; ++kt) { o = MFMA32(ld8(vp + 32 * kt), pf[kt][0], o); o = MFMA32(ld8(vp + 32 * kt + 16), pf[kt][1], o); }
#pragma unroll
        for (int g = 0; g < 4; ++g) { v2u w; w.x = pk2(o[4 * g] * inv, o[4 * g + 1] * inv); w.y = pk2(o[4 * g + 2] * inv, o[4 * g + 3] * inv); *(v2u*)(op + 32 * et + 8 * g + 4 * h2) = w; } }
}


typedef const __attribute__((address_space(4))) Args* kargs_t;
#define KARGS() ({ kargs_t _p = (kargs_t)__builtin_amdgcn_kernarg_segment_ptr(); asm volatile("" : "+s"(_p)); _p; })
#define IN_F(i) ((const float*)ap->in[i])
#define x_in IN_F(0)
#define mem IN_F(1)
#define positions ((const int*)ap->in[2])
#define pre_mix_g IN_F(3)
#define post_mix_g IN_F(4)
#define w_in IN_F(5)
#define conv_w IN_F(6)
#define conv_b IN_F(7)
#define w_rg IN_F(8)
#define b_rg IN_F(9)
#define w_ig IN_F(10)
#define b_ig IN_F(11)
#define lru_lambda IN_F(12)
#define fox_b_f IN_F(13)
#define w_out IN_F(14)
#define pre_cross_g IN_F(15)
#define post_cross_g IN_F(16)
#define mem_norm_g IN_F(17)
#define w_cq IN_F(18)
#define w_ck IN_F(19)
#define w_cv IN_F(20)
#define w_co IN_F(21)
#define pre_ffn_g IN_F(22)
#define post_ffn_g IN_F(23)
#define w_gate IN_F(24)
#define w_up IN_F(25)
#define w_down IN_F(26)
#define xres (ap->out)
#define WSP(off) (ap->ws + (off))
#define WGT ((bf16*)WSP(WS_WGT))
#define LRUSP ((float*)WSP(WS_LRUSP))
#define MEMN ((bf16*)WSP(WS_MEMN))
#define LFT ((float*)WSP(WS_LFT))
#define C2 ((float*)WSP(WS_C2))
#define CARA ((float*)WSP(WS_CARA))
#define CARH ((float*)WSP(WS_CARH))
#define CARIN ((float*)WSP(WS_CARIN))
#define KMEM ((bf16*)WSP(WS_KMEM))
#define VTMEM ((bf16*)WSP(WS_VTMEM))
#define WCK ((bf16*)WSP(WS_WCK))
#define WCV ((bf16*)WSP(WS_WCV))
#define H ((bf16*)WSP(WS_H))
#define MIX ((bf16*)WSP(WS_H))
#define PROJ ((bf16*)WSP(WS_BIG))
#define QC ((bf16*)WSP(WS_BIG))
#define OC ((bf16*)WSP(WS_BIG + 64 * MiB))
#define HFF ((bf16*)WSP(WS_BIG))
#define AA ((float*)WSP(WS_AU))
#define UU ((float*)WSP(WS_AU + 32 * MiB))
#define RAW ((bf16*)WSP(WS_AU))
#define KWT ((bf16*)WSP(WS_KWT))
#define RVT ((bf16*)WSP(WS_RVT))
#define FVT ((bf16*)WSP(WS_FVT))
#define UT ((float*)WSP(WS_UT))
#define PREV ((bf16*)WSP(WS_PREV))
#define WL(off) ((const bf16*)WSP(WS_W + (size_t)l * W_LAYER + (off)))
extern __shared__ __attribute__((aligned(16))) unsigned char g_lds[];
__device__ __forceinline__ void frame_init(Frame& F) {
    int t = threadIdx.x; asm volatile("" : "+v"(t));
    F.lds = (LAS unsigned char*)g_lds;
    F.MISC = (volatile LAS unsigned*)(F.lds + MISC_OFF);
    F.tid = t; F.lane = t & 63; F.wave = __builtin_amdgcn_readfirstlane(t >> 6);
    F.G = gridDim.x; F.gw = blockIdx.x * NWAVES + F.wave; F.NGW = F.G * NWAVES;
}
#define GRID_BAR() xcd_barrier(bar)
#define PH_BEGIN { kargs_t ap = KARGS(); Frame F; frame_init(F);
#define PH_END }
template <int L> __device__ __forceinline__ void layer_fwd(const XcdBarrier& bar) {
    constexpr int l = L;
        if (blockIdx.x < 16) { PH_BEGIN cscan_job(F, LFT, C2, (int)blockIdx.x); PH_END }
        PH_BEGIN
            pg8::Gemm g{H, WL(W_IN), M, NPROJ, D}; pg8::StaticOrder S; S.init(M, NPROJ, F.G, (int)blockIdx.x);
            pg8::EpiPlain E{PROJ, NPROJ, C2FOX, 2, 4};
            pg8::gemm_phase<pg8::EpiPlain, pg8::StaticOrder, true, true>(F.lds + RING_OFF, g, S, E);
        PH_END
        GRID_BAR();
        PH_BEGIN
        for (int u = F.gw; u < 1024 + 512 * 28; u += F.NGW) {
            if (u < 1024) lru_gates_unit(F, u, PROJ, conv_w + (size_t)l * 4 * 256, conv_b + l * 256, WGT + (size_t)l * 2 * 4 * 64 * 64, b_rg + l * 256, b_ig + l * 256, LRUSP + l * 256, AA, UU);
            else { const int v = u - 1024, tt = v / 28, jb = v % 28;
                if (jb < 20) prep_unit(F, tt, jb, PROJ, positions, KWT, RVT, FVT); else fox_knorm_unit(F, tt, jb - 20, PROJ, (unsigned*)WSP(WS_CTL) + CW_FOXK + 16 * l); }
        }
        PH_END
        GRID_BAR();
        PH_BEGIN
        lru_chunk_scan(F, AA, UU, CARA, CARH);
        for (int u = F.gw; u < 1024; u += F.NGW) ret_state_unit(F, u, RVT, KWT, UT);
        PH_END
        GRID_BAR();
        PH_BEGIN
        if (blockIdx.x == 0) lru_carry_scan(F, CARA, CARH, CARIN);
        else if (blockIdx.x <= 64) ret_state_scan(F, ((int)blockIdx.x - 1) * (NWAVES * 64) + F.tid, UT, PREV);
        PH_END
        PH_BEGIN
            const int bh = F.gw >> 7, w = F.gw & 127;
            if (bh < 16) {
#pragma unroll 1
                for (int i = 0; i < 4; ++i) { const int qt = i == 0 ? 511 - w : i == 1 ? 383 - w : i == 2 ? 128 + w : w;
                    fox_unit(F, bh >> 3, bh & 7, qt, PROJ, FVT, C2, MIX, (const unsigned*)WSP(WS_CTL) + CW_FOXK + 16 * l); }
            }
        PH_END
        GRID_BAR();
        PH_BEGIN
        lru_final(F, AA, UU, CARIN, PROJ, MIX);
#pragma unroll 1
        for (int i = 0; i < 2; ++i) { const int u0 = F.gw + i * F.NGW; if (u0 < 4096) { const int u = i == 0 ? u0 : ((((u0 >> 2)) ^ 3) << 2) | (u0 & 3); ret_final_unit(F, u, PROJ, RVT, PREV, MIX); } }
        PH_END
        GRID_BAR();
        PH_BEGIN
            pg8::Gemm g{MIX, WL(W_OUT), M, D, D}; pg8::StaticOrder S; S.init(M, D, F.G, (int)blockIdx.x);
            pg8::EpiPlain E{RAW, D, 1.f, 0, 0};
            pg8::gemm_phase<pg8::EpiPlain, pg8::StaticOrder, true, true>(F.lds + RING_OFF, g, S, E);
        PH_END
        GRID_BAR();
        PH_BEGIN
        thin_pass<true, true, false>(F, RAW, xres, xres, post_mix_g + l * D, pre_cross_g + l * D, H, nullptr, nullptr, nullptr);
        PH_END
        GRID_BAR();
        PH_BEGIN
            pg8::Gemm g{H, WL(W_CQ), M, D, D}; pg8::StaticOrder S; S.init(M, D, F.G, (int)blockIdx.x);
            pg8::EpiPlain E{QC, D, C2CROSS, 0, 4};
            pg8::gemm_phase<pg8::EpiPlain, pg8::StaticOrder, true, true>(F.lds + RING_OFF, g, S, E);
        PH_END
        GRID_BAR();
        PH_BEGIN
#pragma unroll 1
        for (int u = F.gw; u < 4096; u += F.NGW) cross_unit(F, u, QC, KMEM + (size_t)l * D, VTMEM + (size_t)l * D * (BATCH * MEML), OC);
        PH_END
        GRID_BAR();
        PH_BEGIN
            pg8::Gemm g{OC, WL(W_CO), M, D, D}; pg8::StaticOrder S; S.init(M, D, F.G, (int)blockIdx.x);
            pg8::EpiPlain E{RAW, D, 1.f, 0, 0};
            pg8::gemm_phase<pg8::EpiPlain, pg8::StaticOrder, true, true>(F.lds + RING_OFF, g, S, E);
        PH_END
        GRID_BAR();
        PH_BEGIN
        thin_pass<true, true, false>(F, RAW, xres, xres, post_cross_g + l * D, pre_ffn_g + l * D, H, nullptr, nullptr, nullptr);
        PH_END
        GRID_BAR();
        PH_BEGIN
            pg8::Gemm g{H, WL(W_GU), M, 2 * DFF, D}; pg8::StaticOrder S; S.init(M, 2 * DFF, F.G, (int)blockIdx.x);
            pg8::EpiSwiGLU E{HFF, DFF};
            pg8::gemm_phase<pg8::EpiSwiGLU, pg8::StaticOrder, true, true>(F.lds + RING_OFF, g, S, E);
        PH_END
        GRID_BAR();
        PH_BEGIN
            pg8::Gemm g{HFF, WL(W_DN), M, D, DFF}; pg8::StaticOrder S; S.init(M, D, F.G, (int)blockIdx.x);
            pg8::EpiPlain E{RAW, D, 1.f, 0, 0};
            pg8::gemm_phase<pg8::EpiPlain, pg8::StaticOrder, true, true>(F.lds + RING_OFF, g, S, E);
        PH_END
        GRID_BAR();
        if (l == 0) { PH_BEGIN thin_pass<true, true, true>(F, RAW, xres, xres, post_ffn_g + l * D, pre_mix_g + (l + 1) * D, H, w_in + (size_t)(l + 1) * D * INW, fox_b_f + (l + 1) * 8, LFT); PH_END GRID_BAR(); }
        else { PH_BEGIN thin_pass<true, false, false>(F, RAW, xres, xres, post_ffn_g + l * D, nullptr, nullptr, nullptr, nullptr, nullptr); PH_END }
}

__global__ void __launch_bounds__(NWAVES * 64, 2) hymba_fwd(Args args) {
    for (int u = threadIdx.x; u < (LDS_BYTES - LDSCTL_OFF) / 4; u += NWAVES * 64) ((LAS unsigned*)((LAS unsigned char*)g_lds + LDSCTL_OFF))[u] = 0u;
    __syncthreads();
    XcdBarrier bar = xcd_barrier_post((unsigned*)(args.ws + WS_CTL) + CW_BAR, (volatile LAS unsigned*)((LAS unsigned char*)g_lds + MISC_OFF) + 8);
    PH_BEGIN
        LAS float* scr = (LAS float*)(F.lds + RING_OFF + F.wave * 16384);
        constexpr int PER_LAYER = 16 * 96 + 3 * 16 * 32 + 2 * 16 * 88 + 44 * 32 + 2 * 16 * 32;
        for (int it = F.gw; it < 2 * PER_LAYER; it += F.NGW) {
            const int l = it / PER_LAYER; const int r = it % PER_LAYER; int o = 0;
            unsigned char* wl = WSP(WS_W + (size_t)l * W_LAYER);
            o = conv_matrix(F, scr, o, r, w_in + (size_t)l * D * INW, INW, D, 0, NPROJ, (bf16*)(wl + W_IN), 0, 1);
            o = conv_matrix(F, scr, o, r, w_out + (size_t)l * D * D, D, D, 0, D, (bf16*)(wl + W_OUT), 0, 0);
            o = conv_matrix(F, scr, o, r, w_cq + (size_t)l * D * D, D, D, 0, D, (bf16*)(wl + W_CQ), 0, 0);
            o = conv_matrix(F, scr, o, r, w_co + (size_t)l * D * D, D, D, 0, D, (bf16*)(wl + W_CO), 0, 0);
            o = conv_matrix(F, scr, o, r, w_gate + (size_t)l * D * DFF, DFF, D, 0, DFF, (bf16*)(wl + W_GU), 0, 2);
            o = conv_matrix(F, scr, o, r, w_up + (size_t)l * D * DFF, DFF, D, 0, DFF, (bf16*)(wl + W_GU), 0, 3);
            o = conv_matrix(F, scr, o, r, w_down + (size_t)l * DFF * D, D, DFF, 0, D, (bf16*)(wl + W_DN), 0, 0);
            o = conv_matrix(F, scr, o, r, w_ck + (size_t)l * D * D, D, D, 0, D, WCK + (size_t)l * D * D, 0, 0);
            o = conv_matrix(F, scr, o, r, w_cv + (size_t)l * D * D, D, D, 0, D, WCV + (size_t)l * D * D, 0, 0);
        }
        for (int e = blockIdx.x * (NWAVES * 64) + F.tid; e < 2 * 2 * 4 * 64 * 64; e += F.G * NWAVES * 64) {
            const int i = e & 63, j = (e >> 6) & 63, blk = (e >> 12) & 3, gate = (e >> 14) & 1, l = e >> 15;
            const float* src = gate ? w_ig : w_rg; WGT[e] = (bf16)(pk2(src[(((size_t)l * 4 + blk) * 64 + i) * 64 + j], 0.f) & 0xffffu);
        }
        if (blockIdx.x == 0) { const int e = F.tid; const float lam = lru_lambda[e]; LRUSP[e] = 8.0f * log1pf(expf(-lam)); }
        for (int row = F.gw; row < BATCH * MEML; row += F.NGW) {
            f32x4 v[4]; float ss = 0.f;
#pragma unroll
            for (int j = 0; j < 4; ++j) { v[j] = *(const f32x4*)(mem + (size_t)row * D + 4 * F.lane + 256 * j); ss += (v[j][0] * v[j][0] + v[j][1] * v[j][1]) + (v[j][2] * v[j][2] + v[j][3] * v[j][3]); }
            const float rstd = 1.0f / sqrtf(wave_sum(ss) * (1.0f / D) + EPS);
#pragma unroll
            for (int j = 0; j < 4; ++j) { const f32x4 g = *(const f32x4*)(mem_norm_g + 4 * F.lane + 256 * j); v2u w; w.x = pk2(v[j][0] * rstd * g[0], v[j][1] * rstd * g[1]); w.y = pk2(v[j][2] * rstd * g[2], v[j][3] * rstd * g[3]);
                *(v2u*)(MEMN + (size_t)row * D + 4 * F.lane + 256 * j) = w; }
        }
        __syncthreads();
    PH_END
    PH_BEGIN
        thin_pass<false, true, true>(F, nullptr, x_in, xres, nullptr, pre_mix_g, H, w_in, fox_b_f, LFT);
    PH_END
    GRID_BAR();
    PH_BEGIN
        pg8::Gemm g{MEMN, WCK, BATCH * MEML, 2 * D, D}; pg8::StaticOrder S; S.init(BATCH * MEML, 2 * D, F.G, (int)blockIdx.x);
        pg8::EpiPlain E{KMEM, 2 * D, 1.f, 0, 0};
        pg8::gemm_phase<pg8::EpiPlain, pg8::StaticOrder, true, true>(F.lds + RING_OFF, g, S, E);
    PH_END
    PH_BEGIN
        pg8::Gemm g{WCV, MEMN, 2 * D, BATCH * MEML, D}; pg8::StaticOrder S; S.init(2 * D, BATCH * MEML, F.G, (int)((blockIdx.x + F.G - 16) % F.G));
        pg8::EpiPlain E{VTMEM, BATCH * MEML, 1.f, 0, 0};
        pg8::gemm_phase<pg8::EpiPlain, pg8::StaticOrder, true, true>(F.lds + RING_OFF, g, S, E);
    PH_END

    layer_fwd<0>(bar);
    layer_fwd<1>(bar);
}

extern "C" void kernel_launch(void* const* d_in, const int* in_sizes, int n_in, void* d_out, int out_size, void* d_ws, size_t ws_size, hipStream_t stream) {
    static int grid = 0;
    if (grid == 0) {
        if (n_in != 27 || in_sizes[0] != M * D || out_size != M * D || ws_size < WS_END) { fprintf(stderr, "kernel_launch: unexpected shapes / workspace (n_in %d, ws %zu, need %zu); nothing launched\n", n_in, ws_size, (size_t)WS_END); grid = -1; return; }
        int dev = 0, cus = 0;
        if (hipGetDevice(&dev) != hipSuccess || hipDeviceGetAttribute(&cus, hipDeviceAttributeMultiprocessorCount, dev) != hipSuccess) { grid = -1; return; }
        if (hipFuncSetAttribute((const void*)hymba_fwd, hipFuncAttributeMaxDynamicSharedMemorySize, LDS_BYTES) != hipSuccess) { fprintf(stderr, "kernel_launch: hipFuncSetAttribute failed\n"); grid = -1; return; }
        (void)hipGetLastError();
        grid = cus < 256 ? cus : 256;
    }
    if (grid < 0) return;
    if (hipMemsetAsync((char*)d_ws + WS_CTL, 0, CTL_ZERO_BYTES, stream) != hipSuccess) return;
    Args a{};
    for (int i = 0; i < 27; ++i) a.in[i] = (const float*)d_in[i];
    a.out = (float*)d_out; a.ws = (unsigned char*)d_ws;
    hipLaunchKernelGGL(hymba_fwd, dim3(grid), dim3(NWAVES * 64), LDS_BYTES, stream, a);
}
```

```cpp
#include <hip/hip_runtime.h>
#include <cstdio>
#include <cstdint>
namespace pg8 {
#define PG8_LAS __attribute__((address_space(3)))
typedef unsigned short bf16_t;
typedef short bf16x8 __attribute__((ext_vector_type(8)));
typedef float f32x4 __attribute__((ext_vector_type(4)));
typedef unsigned u32x4 __attribute__((ext_vector_type(4)));
constexpr int BM = 256, BK = 64, HALF = 128, HTB = HALF * BK * 2  , STAGE_BYTES = 8 * HTB, NXCD = 8, WGM = 8;

__host__ __device__ __forceinline__ int lds_byte(int r, int c) { const int st = (r >> 4) * 2 + (c >> 5), rr = r & 15, cc = c & 31, ob = rr * 64 + cc * 2; return st * 1024 + (ob ^ (((ob >> 9) & 1) << 5)); }
__host__ __device__ __forceinline__ void stage_rc(int b, int& R, int& C) { const int st = b / 1024, sb = b % 1024, swz = sb ^ (((sb >> 9) & 1) << 5); R = (st >> 1) * 16 + swz / 64; C = (st & 1) * 32 + (swz % 64) / 2; }
__host__ __device__ __forceinline__ int perm32(int rho) { const int n = rho >> 4, i = rho & 15; return 8 * (i >> 2) + 4 * n + (i & 3); }

struct Unit { int pm, pn; };
struct Gemm;
struct Gemm { const bf16_t* A; const bf16_t* Bt; int M, N, K; int sw_lo = 0, sw_hi = 0; size_t bb_stride = 0; int bb_shift = 30;     __host__ __device__ bool swapped(const Unit& u) const { return u.pn >= sw_lo && u.pn < sw_hi; } };

struct StaticOrder {
    int nM, nN, nwg, G, c;
    __host__ __device__ __forceinline__ void init(int M, int N, int G_, int c_) { nM = M / BM; nN = N / BM; nwg = nM * nN; G = G_; c = c_; }
    __host__ __device__ __forceinline__ bool next(int i, Unit& u) const {
        const long L = (long)i * G + c; if (L >= nwg) return false;
        int wgid = (int)L; { const int q = nwg / NXCD, r = nwg % NXCD, xcd = wgid % NXCD, off = wgid / NXCD; wgid = (xcd < r ? xcd * (q + 1) : r * (q + 1) + (xcd - r) * q) + off; }
        const int nig = WGM * nN, gid = wgid / nig, fm = gid * WGM, gsz = (nM - fm) < WGM ? (nM - fm) : WGM;
        u.pm = fm + ((wgid % nig) % gsz); u.pn = (wgid % nig) / gsz; return true;
    }
    __device__ __forceinline__ void a_ready(const Unit&) const {}
    __device__ __forceinline__ void done(const Unit&) const {}
};


typedef float f32x2 __attribute__((ext_vector_type(2)));
typedef __bf16 bf16x2_t __attribute__((ext_vector_type(2)));
__device__ __forceinline__ unsigned cvt_pk_bf16(float lo, float hi) { f32x2 v = {lo, hi}; bf16x2_t b = __builtin_convertvector(v, bf16x2_t); return __builtin_bit_cast(unsigned, b); }

struct EpiPlain {
    static constexpr bool PERM = true, AFTER_DRAIN = false;
    bf16_t* O; int ldc; float sc; int sc_lo, sc_hi; const float* rs; bf16_t* O1; int ldc1, nsplit;
    __device__ __forceinline__ void operator()(const f32x4 (&acc)[2][2][4][2], const Unit& u, int wr, int wc, int fr, int fq) const {
        const int row0 = u.pm * BM + wr * 64 + fr;
        bf16_t* base = O; int ld = ldc, pn = u.pn; if (pn >= nsplit) { base = O1; ld = ldc1; pn -= nsplit; }
        const int col0 = pn * BM + wc * 32 + 8 * fq;
        const float s = (u.pn >= sc_lo && u.pn < sc_hi) ? sc : 1.f;
#pragma unroll
        for (int ai = 0; ai < 2; ++ai)
#pragma unroll
            for (int m = 0; m < 4; ++m) { const int row = row0 + ai * HALF + m * 16; bf16_t* rowp = base + (size_t)row * ld + col0;
                const float sr = rs ? rs[row] * s : s;
#pragma unroll
                for (int bj = 0; bj < 2; ++bj) { const f32x4 v0 = acc[ai][bj][m][0] * sr, v1 = acc[ai][bj][m][1] * sr;
                    u32x4 w; w.x = cvt_pk_bf16(v0[0], v0[1]); w.y = cvt_pk_bf16(v0[2], v0[3]); w.z = cvt_pk_bf16(v1[0], v1[1]); w.w = cvt_pk_bf16(v1[2], v1[3]);
                    *(u32x4*)(rowp + bj * HALF) = w; } }
    }
};
struct EpiProj {
    static constexpr bool PERM = true, AFTER_DRAIN = false;
    bf16_t* PKp; int ldk; bf16_t* PTp; int ldt; float sc; const float* rs; bf16_t* vf; bf16_t* rvf; bf16_t* kf;
    __device__ __forceinline__ void operator()(const f32x4 (&acc)[2][2][4][2], const Unit& u, int wr, int wc, int fr, int fq) const {
        if (u.pn < 7) {
            const int row0 = u.pm * BM + wr * 64 + fr;
            bf16_t* base = PKp; int ld = ldk, pn = u.pn; if (pn >= 5) { base = PTp; ld = ldt; pn -= 5; }
            const int col0 = pn * BM + wc * 32 + 8 * fq;
            const float s = (u.pn == 1 || u.pn == 2) ? sc : 1.f;
#pragma unroll
            for (int ai = 0; ai < 2; ++ai)
#pragma unroll
                for (int m = 0; m < 4; ++m) { const int row = row0 + ai * HALF + m * 16; bf16_t* rowp = base + (size_t)row * ld + col0;
                    const float sr = rs[row] * s;
#pragma unroll
                    for (int bj = 0; bj < 2; ++bj) { const f32x4 v0 = acc[ai][bj][m][0] * sr, v1 = acc[ai][bj][m][1] * sr;
                        u32x4 w; w.x = cvt_pk_bf16(v0[0], v0[1]); w.y = cvt_pk_bf16(v0[2], v0[3]); w.z = cvt_pk_bf16(v1[0], v1[1]); w.w = cvt_pk_bf16(v1[2], v1[3]);
                        *(u32x4*)(rowp + bj * HALF) = w; } }
        } else if (u.pn < 9) {
            const int b = u.pm >> 6;
#pragma unroll
            for (int ai = 0; ai < 2; ++ai)
#pragma unroll
                for (int m = 0; m < 4; ++m) { const int rt = ai * HALF + wr * 64 + m * 16 + fr; const int tb = (u.pm & 63) * BM + rt;
                    const float sr = rs[u.pm * BM + rt];
                    const int rl = tb & 31, rsw = (rl & 0x13) | ((rl & 4) << 1) | ((rl & 8) >> 1);
#pragma unroll
                    for (int bj = 0; bj < 2; ++bj) { const int c = 256 * (u.pn - 7) + bj * HALF + wc * 32 + 8 * fq; const int h = c >> 6, ch = (c & 63) >> 3;
                        bf16_t* dst = kf + ((size_t)((((b * 8 + h) * 512 + (tb >> 5)) * 4 + (ch >> 1)) * 64) + rsw + 32 * (ch & 1)) * 8;
                        const f32x4 v0 = acc[ai][bj][m][0] * sr, v1 = acc[ai][bj][m][1] * sr;
                        u32x4 w; w.x = cvt_pk_bf16(v0[0], v0[1]); w.y = cvt_pk_bf16(v0[2], v0[3]); w.z = cvt_pk_bf16(v1[0], v1[1]); w.w = cvt_pk_bf16(v1[2], v1[3]);
                        *(u32x4*)dst = w; } }
        } else {
            const int b = u.pm >> 6;
#pragma unroll
            for (int bj = 0; bj < 2; ++bj) {
                const int c0 = bj * HALF + wc * 32 + 8 * fq; const int tb = (u.pm & 63) * BM + c0;
                const f32x4 r0 = *(const f32x4*)(rs + u.pm * BM + c0), r1 = *(const f32x4*)(rs + u.pm * BM + c0 + 4);
                const int h2 = (tb >> 3) & 1;
#pragma unroll
                for (int ai = 0; ai < 2; ++ai)
#pragma unroll
                    for (int m = 0; m < 4; ++m) { const int f = ai * HALF + wr * 64 + m * 16 + fr;
                        const int e = f & 63, et = e >> 5, re = e & 31; bf16_t* dst;
                        if (u.pn < 11) { const int h = (256 * (u.pn - 9) + f) >> 6; dst = vf + ((size_t)((((b * 8 + h) * 512 + (tb >> 5)) * 4 + 2 * et + ((tb >> 4) & 1)) * 64) + re + 32 * h2) * 8; }
                        else { const int h = f >> 6; dst = rvf + ((size_t)(((((b * 128 + (tb >> 7)) * 4 + h) * 2 + et) * 8 + ((tb >> 4) & 7)) * 64) + re + 32 * h2) * 8; }
                        const f32x4 v0 = acc[ai][bj][m][0] * r0, v1 = acc[ai][bj][m][1] * r1;
                        u32x4 w; w.x = cvt_pk_bf16(v0[0], v0[1]); w.y = cvt_pk_bf16(v0[2], v0[3]); w.z = cvt_pk_bf16(v1[0], v1[1]); w.w = cvt_pk_bf16(v1[2], v1[3]);
                        *(u32x4*)dst = w; }
            }
        }
    }
};
struct EpiBlock {
    static constexpr bool PERM = true, AFTER_DRAIN = false;
    bf16_t* O; int ldc, mode;
    __device__ __forceinline__ void operator()(const f32x4 (&acc)[2][2][4][2], const Unit& u, int wr, int wc, int fr, int fq) const {
        int rb, cb;
        if (mode == 2) { rb = (((u.pn >> 2) * 2 + u.pm) * 4 + (u.pn & 3)) * 256; cb = 0; }
        else if (mode == 0) { rb = (u.pm >> 2) * 1024 + (u.pm & 3) * 256; cb = (u.pn & 3) * 256; }
        else { rb = (u.pn >> 2) * 1024 + (u.pm & 3) * 256; cb = (u.pn & 3) * 256; }
        const int row0 = rb + wr * 64 + fr, col0 = cb + wc * 32 + 8 * fq;
#pragma unroll
        for (int ai = 0; ai < 2; ++ai)
#pragma unroll
            for (int m = 0; m < 4; ++m) { bf16_t* rowp = O + (size_t)(row0 + ai * HALF + m * 16) * ldc + col0;
#pragma unroll
                for (int bj = 0; bj < 2; ++bj) { const f32x4 v0 = acc[ai][bj][m][0], v1 = acc[ai][bj][m][1];
                    u32x4 w; w.x = cvt_pk_bf16(v0[0], v0[1]); w.y = cvt_pk_bf16(v0[2], v0[3]); w.z = cvt_pk_bf16(v1[0], v1[1]); w.w = cvt_pk_bf16(v1[2], v1[3]);
                    *(u32x4*)(rowp + bj * HALF) = w; } }
    }
};
struct PairOrder {
    int c; bool vw;
    __host__ __device__ __forceinline__ bool next(int i, Unit& u) const {
        if (i != 0 || c < 0 || c >= 64) return false;
        const int nt = c & 3, q = c >> 2, hc = q & 3, lb = q >> 2, l = lb >> 1;
        if (!vw) { u.pm = q; u.pn = (l * 4 + hc) * 4 + nt; } else { u.pm = (l * 4 + hc) * 4 + nt; u.pn = q; }
        return true;
    }
    __device__ __forceinline__ void a_ready(const Unit&) const {}
    __device__ __forceinline__ void done(const Unit&) const {}
};
struct EpiSoftmax {
    static constexpr bool PERM = true, AFTER_DRAIN = false;
    bf16_t* O; const float* rs; PG8_LAS float* ex;
    __device__ __forceinline__ void operator()(f32x4 (&acc)[2][2][4][2], const Unit& u, int wr, int wc, int fr, int fq) const {
        typedef float f32x2v __attribute__((ext_vector_type(2)));
        PG8_LAS f32x2v* EX = (PG8_LAS f32x2v*)ex;
#pragma unroll
        for (int ai = 0; ai < 2; ++ai)
#pragma unroll
            for (int m = 0; m < 4; ++m) { const int rl = ai * HALF + wr * 64 + m * 16 + fr; const float sr = rs[u.pm * BM + rl];
                float mx = -3.0e38f;
#pragma unroll
                for (int bj = 0; bj < 2; ++bj)
#pragma unroll
                    for (int n = 0; n < 2; ++n) { f32x4 x = acc[ai][bj][m][n] * sr; acc[ai][bj][m][n] = x; mx = fmaxf(fmaxf(mx, fmaxf(x[0], x[1])), fmaxf(x[2], x[3])); }
                mx = fmaxf(mx, __shfl_xor(mx, 16)); mx = fmaxf(mx, __shfl_xor(mx, 32));
                float sm = 0.f;
#pragma unroll
                for (int bj = 0; bj < 2; ++bj)
#pragma unroll
                    for (int n = 0; n < 2; ++n) { f32x4 x = acc[ai][bj][m][n];
                        x[0] = __builtin_amdgcn_exp2f(x[0] - mx); x[1] = __builtin_amdgcn_exp2f(x[1] - mx); x[2] = __builtin_amdgcn_exp2f(x[2] - mx); x[3] = __builtin_amdgcn_exp2f(x[3] - mx);
                        acc[ai][bj][m][n] = x; sm += (x[0] + x[1]) + (x[2] + x[3]); }
                sm += __shfl_xor(sm, 16); sm += __shfl_xor(sm, 32);
                if (fq == 0) EX[rl * 4 + wc] = (f32x2v){mx, sm}; }
        asm volatile("s_waitcnt lgkmcnt(0)" ::: "memory"); __builtin_amdgcn_s_barrier(); asm volatile("" ::: "memory");
        const int row0 = u.pm * BM + wr * 64 + fr, col0 = u.pn * BM + wc * 32 + 8 * fq;
#pragma unroll
        for (int ai = 0; ai < 2; ++ai)
#pragma unroll
            for (int m = 0; m < 4; ++m) { const int rl = ai * HALF + wr * 64 + m * 16 + fr;
                const f32x2v e0 = EX[rl * 4 + 0], e1 = EX[rl * 4 + 1], e2 = EX[rl * 4 + 2], e3 = EX[rl * 4 + 3];
                const float ma = fmaxf(fmaxf(e0.x, e1.x), fmaxf(e2.x, e3.x));
                const float sa = (e0.y * __builtin_amdgcn_exp2f(e0.x - ma) + e1.y * __builtin_amdgcn_exp2f(e1.x - ma)) + (e2.y * __builtin_amdgcn_exp2f(e2.x - ma) + e3.y * __builtin_amdgcn_exp2f(e3.x - ma));
                const float mine = wc == 0 ? e0.x : wc == 1 ? e1.x : wc == 2 ? e2.x : e3.x;
                const float f = __builtin_amdgcn_exp2f(mine - ma) * __builtin_amdgcn_rcpf(sa);
                bf16_t* rowp = O + (size_t)(row0 + ai * HALF + m * 16) * 1024 + col0;
#pragma unroll
                for (int bj = 0; bj < 2; ++bj) { const f32x4 v0 = acc[ai][bj][m][0] * f, v1 = acc[ai][bj][m][1] * f;
                    u32x4 w; w.x = cvt_pk_bf16(v0[0], v0[1]); w.y = cvt_pk_bf16(v0[2], v0[3]); w.z = cvt_pk_bf16(v1[0], v1[1]); w.w = cvt_pk_bf16(v1[2], v1[3]);
                    *(u32x4*)(rowp + bj * HALF) = w; } }
    }
};
struct EpiSwiGLU {
    static constexpr bool PERM = true, AFTER_DRAIN = false;
    bf16_t* O; int ldc; const float* rs;
    __device__ __forceinline__ void operator()(const f32x4 (&acc)[2][2][4][2], const Unit& u, int wr, int wc, int fr, int fq) const {
        const int row0 = u.pm * BM + wr * 64 + fr; const int col0 = u.pn * HALF + wc * 32 + 8 * fq;
#pragma unroll
        for (int ai = 0; ai < 2; ++ai)
#pragma unroll
            for (int m = 0; m < 4; ++m) { const int row = row0 + ai * HALF + m * 16; bf16_t* rowp = O + (size_t)row * ldc + col0;
                const float sr = rs[row];
                float o[8];
#pragma unroll
                for (int n = 0; n < 2; ++n)
#pragma unroll
                    for (int i = 0; i < 4; ++i) { const float g = acc[ai][0][m][n][i] * sr, up = acc[ai][1][m][n][i] * sr;
                        const float sg = g * __builtin_amdgcn_rcpf(1.0f + __builtin_amdgcn_exp2f(-1.4426950408889634f * g)); o[4 * n + i] = sg * up; }
                u32x4 w; w.x = cvt_pk_bf16(o[0], o[1]); w.y = cvt_pk_bf16(o[2], o[3]); w.z = cvt_pk_bf16(o[4], o[5]); w.w = cvt_pk_bf16(o[6], o[7]);
                *(u32x4*)rowp = w; }
    }
};

template <class Epi, class Sched, bool ALIGN_EPI = false, bool SP2 = false>
__device__ __forceinline__ void gemm_phase(PG8_LAS unsigned char* lds, const Gemm g, const Sched& S, const Epi& E) {
    int tid_ = threadIdx.x; asm volatile("" : "+v"(tid_));
    const int tid = tid_, wid = __builtin_amdgcn_readfirstlane(tid >> 6), lane = tid & 63, wr = wid >> 2, wc = wid & 3, fr = lane & 15, fq = lane >> 4;
    const int K = g.K, nt = K / BK;
    unsigned voffA[2], voffB[2];
#pragma unroll
    for (int i = 0; i < 2; ++i) { int R, C; stage_rc(tid * 16 + i * 8192, R, C); const int Rb = Epi::PERM ? ((R & ~31) + perm32(R & 31)) : R;
        voffA[i] = (unsigned)(R * K + C) * 2u; voffB[i] = (unsigned)(Rb * K + C) * 2u; }
    const size_t kstep = (size_t)(BK * 2);
    const size_t hstep = (size_t)HALF * K * 2;
    const size_t tstep = 2 * hstep;
    const unsigned ldsw = (unsigned)wid * 1024u;
    const int aoff = lds_byte(wr * 64 + fr, fq * 8), boff = lds_byte(wc * 32 + fr, fq * 8);
#define PG8_SA(b, h) (((b) * 2 + (h)) * HTB)
#define PG8_SB(b, h) ((4 + (b) * 2 + (h)) * HTB)
#define PG8_STAGE(bufoff, gbase, voff) do { _Pragma("unroll") for (int _i = 0; _i < 2; ++_i) \
        __builtin_amdgcn_global_load_lds((const unsigned*)((const char*)(gbase) + (voff)[_i]), (PG8_LAS unsigned*)(lds + (bufoff) + ldsw + _i * 8192), 16, 0, 0); } while (0)
#define PG8_LDA(dst, b, h) do { _Pragma("unroll") for (int m = 0; m < 4; ++m) _Pragma("unroll") for (int k = 0; k < 2; ++k) dst[m][k] = *(const PG8_LAS bf16x8*)(lds + PG8_SA(b, h) + aoff + m * 2048 + k * 1024); } while (0)
#define PG8_LDB(dst, b, h) do { _Pragma("unroll") for (int n = 0; n < 2; ++n) _Pragma("unroll") for (int k = 0; k < 2; ++k) dst[n][k] = *(const PG8_LAS bf16x8*)(lds + PG8_SB(b, h) + boff + n * 2048 + k * 1024); } while (0)
#define PG8_MMA(ai, bj, At, Bt) do { __builtin_amdgcn_s_setprio(1); _Pragma("unroll") for (int m = 0; m < 4; ++m) _Pragma("unroll") for (int n = 0; n < 2; ++n) _Pragma("unroll") for (int k = 0; k < 2; ++k) \
        acc[ai][bj][m][n] = __builtin_amdgcn_mfma_f32_16x16x32_bf16(Bt[n][k], At[m][k], acc[ai][bj][m][n], 0, 0, 0); __builtin_amdgcn_s_setprio(0); } while (0)
#define PG8_WAIT_V(n) asm volatile("s_waitcnt vmcnt(" #n ")" ::: "memory")
#define PG8_WAIT_L(n) asm volatile("s_waitcnt lgkmcnt(" #n ")" ::: "memory")
#define PG8_BAR __builtin_amdgcn_s_barrier()
#define PG8_SCHED __builtin_amdgcn_sched_barrier(0)
    Unit cur, nxt; int ui = 0;
    if (!S.next(0, cur)) return;
    f32x4 acc[2][2][4][2];
#pragma unroll
    for (int a = 0; a < 2; ++a)
#pragma unroll
        for (int b = 0; b < 2; ++b)
#pragma unroll
            for (int m = 0; m < 4; ++m)
#pragma unroll
                for (int n = 0; n < 2; ++n) acc[a][b][m][n] = (f32x4){0.f, 0.f, 0.f, 0.f};
    bf16x8 At[4][2], B0[2][2], B1[2][2];
    const char* cA = (const char*)g.A + (size_t)cur.pm * tstep; const char* cB = (const char*)g.Bt + (size_t)cur.pn * tstep + (size_t)(cur.pm >> g.bb_shift) * g.bb_stride;
    if (g.swapped(cur)) { const char* t_ = cA; cA = cB; cB = t_; }
    S.a_ready(cur);
    if constexpr (SP2) {
        PG8_STAGE(PG8_SB(0, 0), cB, voffB); PG8_STAGE(PG8_SB(0, 1), cB + hstep, voffB); PG8_STAGE(PG8_SA(0, 0), cA, voffA); PG8_STAGE(PG8_SA(0, 1), cA + hstep, voffA);
        if (wr == 1) PG8_BAR;
        PG8_WAIT_V(2); PG8_BAR;
        PG8_STAGE(PG8_SB(1, 0), cB + kstep, voffB); PG8_STAGE(PG8_SA(1, 0), cA + kstep, voffA); PG8_STAGE(PG8_SB(1, 1), cB + hstep + kstep, voffB);
        PG8_WAIT_V(6); PG8_BAR;
    } else {
        PG8_STAGE(PG8_SB(0, 0), cB, voffB); PG8_STAGE(PG8_SA(0, 0), cA, voffA); PG8_STAGE(PG8_SB(0, 1), cB + hstep, voffB); PG8_STAGE(PG8_SA(0, 1), cA + hstep, voffA);
        if (wr == 1) PG8_BAR;
        PG8_WAIT_V(4); PG8_BAR;
        PG8_STAGE(PG8_SB(1, 0), cB + kstep, voffB); PG8_STAGE(PG8_SA(1, 0), cA + kstep, voffA); PG8_STAGE(PG8_SB(1, 1), cB + hstep + kstep, voffB);
        PG8_WAIT_V(6); PG8_BAR;
    }
    for (;;) {
        const bool has_next = S.next(ui + 1, nxt);
        const char* nA = has_next ? (const char*)g.A + (size_t)nxt.pm * tstep : cA; const char* nB = has_next ? (const char*)g.Bt + (size_t)nxt.pn * tstep + (size_t)(nxt.pm >> g.bb_shift) * g.bb_stride : cB;
        if (has_next && g.swapped(nxt)) { const char* t_ = nA; nA = nB; nB = t_; }
        for (int t = 0; t < nt; t += 2) {
            const bool last = (t == nt - 2);
            const char* a1 = cA + (size_t)(t + 1) * kstep;
            const char* a2 = last ? nA : cA + (size_t)(t + 2) * kstep; const char* b2 = last ? nB : cB + (size_t)(t + 2) * kstep;
            const char* a3 = a2 + kstep; const char* b3 = b2 + kstep;
            if (last && has_next) S.a_ready(nxt);
            if constexpr (SP2) {
            PG8_LDB(B0, 0, 0); PG8_LDB(B1, 0, 1); PG8_SCHED; PG8_LDA(At, 0, 0); PG8_STAGE(PG8_SA(1, 1), a1 + hstep, voffA);
            PG8_WAIT_V(8); PG8_WAIT_L(0); PG8_BAR; PG8_MMA(0, 0, At, B0); PG8_MMA(0, 1, At, B1); PG8_BAR; PG8_SCHED;
            PG8_LDA(At, 0, 1); PG8_STAGE(PG8_SB(0, 0), b2, voffB); PG8_STAGE(PG8_SB(0, 1), b2 + hstep, voffB); PG8_STAGE(PG8_SA(0, 0), a2, voffA);
            PG8_WAIT_V(8); PG8_WAIT_L(0); PG8_BAR; PG8_MMA(1, 0, At, B0); PG8_MMA(1, 1, At, B1); PG8_BAR; PG8_SCHED;
            PG8_LDB(B0, 1, 0); PG8_LDB(B1, 1, 1); PG8_SCHED; PG8_LDA(At, 1, 0); PG8_STAGE(PG8_SA(0, 1), a2 + hstep, voffA);
            PG8_WAIT_V(8); PG8_WAIT_L(0); PG8_BAR; PG8_MMA(0, 0, At, B0); PG8_MMA(0, 1, At, B1); PG8_BAR; PG8_SCHED;
            PG8_LDA(At, 1, 1); PG8_STAGE(PG8_SB(1, 0), b3, voffB); PG8_STAGE(PG8_SB(1, 1), b3 + hstep, voffB); PG8_STAGE(PG8_SA(1, 0), a3, voffA);
            PG8_WAIT_V(8); PG8_WAIT_L(0); PG8_BAR; PG8_MMA(1, 0, At, B0); PG8_MMA(1, 1, At, B1); PG8_BAR; PG8_SCHED;
            } else {
            PG8_LDB(B0, 0, 0); PG8_SCHED; PG8_LDA(At, 0, 0); PG8_STAGE(PG8_SA(1, 1), a1 + hstep, voffA);
            PG8_WAIT_L(8); PG8_BAR; PG8_WAIT_L(0); PG8_MMA(0, 0, At, B0); PG8_BAR; PG8_SCHED;
            PG8_LDB(B1, 0, 1); PG8_STAGE(PG8_SB(0, 0), b2, voffB);
            PG8_BAR; PG8_WAIT_L(0); PG8_MMA(0, 1, At, B1); PG8_BAR;
            PG8_LDA(At, 0, 1); PG8_STAGE(PG8_SA(0, 0), a2, voffA);
            PG8_BAR; PG8_WAIT_L(0); PG8_MMA(1, 0, At, B0); PG8_BAR; PG8_SCHED;
            PG8_STAGE(PG8_SB(0, 1), b2 + hstep, voffB);
            PG8_WAIT_V(6); PG8_BAR; PG8_MMA(1, 1, At, B1); PG8_BAR;
            PG8_LDB(B0, 1, 0); PG8_SCHED; PG8_LDA(At, 1, 0); PG8_STAGE(PG8_SA(0, 1), a2 + hstep, voffA);
            PG8_WAIT_L(8); PG8_BAR; PG8_WAIT_L(0); PG8_MMA(0, 0, At, B0); PG8_BAR; PG8_SCHED;
            PG8_LDB(B1, 1, 1); PG8_STAGE(PG8_SB(1, 0), b3, voffB);
            PG8_BAR; PG8_WAIT_L(0); PG8_MMA(0, 1, At, B1); PG8_BAR;
            PG8_LDA(At, 1, 1); PG8_STAGE(PG8_SA(1, 0), a3, voffA);
            PG8_BAR; PG8_WAIT_L(0); PG8_MMA(1, 0, At, B0); PG8_BAR; PG8_SCHED;
            PG8_STAGE(PG8_SB(1, 1), b3 + hstep, voffB);
            PG8_WAIT_V(6); PG8_BAR; PG8_MMA(1, 1, At, B1); PG8_BAR;
            }
        }
        if constexpr (ALIGN_EPI) { if (wr == 0) PG8_BAR; }
        if constexpr (!Epi::AFTER_DRAIN) { E(acc, cur, wr, wc, fr, fq); S.done(cur); }
        if (!has_next) break;
#pragma unroll
        for (int a = 0; a < 2; ++a)
#pragma unroll
            for (int b = 0; b < 2; ++b)
#pragma unroll
                for (int m = 0; m < 4; ++m)
#pragma unroll
                    for (int n = 0; n < 2; ++n) acc[a][b][m][n] = (f32x4){0.f, 0.f, 0.f, 0.f};
        cur = nxt; cA = nA; cB = nB; ++ui;
        if constexpr (ALIGN_EPI) { if (wr == 1) PG8_BAR; }
    }
    PG8_WAIT_V(0);
    if constexpr (!ALIGN_EPI) { if (wr == 0) PG8_BAR; }
    PG8_BAR;
    if constexpr (Epi::AFTER_DRAIN) { E.fused(acc, cur, wr, wc, fr, fq, lds, wid, lane); S.done(cur); }
#undef PG8_SA
#undef PG8_SB
#undef PG8_STAGE
#undef PG8_LDA
#undef PG8_LDB
#undef PG8_MMA
#undef PG8_WAIT_V
#undef PG8_WAIT_L
#undef PG8_BAR
#undef PG8_SCHED
}
}

constexpr int NWAVES = 8;
constexpr int BATCH = 2, SEQ = 16384, M = BATCH * SEQ, D = 1024, NPROJ = 3072, INW = 3080, DFF = 2816, MEML = 256;
constexpr int PKN = 1280, PTN = 512;
constexpr int K_LY = 0, K_FQ = 256, K_RQ = 768, K_RG = 1024, T_LX = 0, T_RK = 256;
constexpr float EPS = 1e-6f;
constexpr float LOG2E = 1.4426950408889634f;
constexpr float C2FOX = 0.125f * 1.4426950408889634f;
constexpr float C2CROSS = 0.0625f * 1.4426950408889634f;
#ifndef FOX_PRUNE
#define FOX_PRUNE 0
#endif

constexpr size_t MiB = 1u << 20, KiB = 1u << 10;
constexpr size_t WS_CTL = 0, CTL_ZERO_BYTES = 1 * MiB;
constexpr size_t WS_WGT = 1 * MiB;
constexpr size_t WS_LRUSP = WS_WGT + 128 * KiB;
constexpr size_t WS_RSTD = WS_WGT + 256 * KiB;
constexpr size_t WS_FOXMAX = WS_LRUSP + 4 * KiB;
constexpr size_t WS_MEMN = 2 * MiB;
constexpr size_t WS_LFT = 3 * MiB;
constexpr size_t WS_C2 = 4 * MiB;
constexpr size_t WS_CARA = 5 * MiB, WS_CARH = 6 * MiB, WS_CARIN = 11 * MiB;
constexpr size_t WS_KMEM = 7 * MiB;
constexpr size_t WS_VTMEM = 9 * MiB;
constexpr size_t WS_W = 12 * MiB;
constexpr size_t W_IN = 0, W_OUT = W_IN + (size_t)NPROJ * D * 2, W_CQ = W_OUT + (size_t)D * D * 2, W_CO = W_CQ + (size_t)D * D * 2,
                 W_GU = W_CO + (size_t)D * D * 2, W_DN = W_GU + (size_t)2 * DFF * D * 2, W_LAYER = W_DN + (size_t)D * DFF * 2;
constexpr size_t WS_WCK = WS_W + 2 * W_LAYER, WS_WCV = WS_WCK + (size_t)2 * D * D * 2, WS_WEND = WS_WCV + (size_t)2 * D * D * 2;
constexpr size_t WS_H = 77 * MiB;
constexpr size_t WS_BIG = 141 * MiB;
constexpr size_t WS_PT = WS_BIG + (size_t)M * PKN * 2;
constexpr size_t WS_AU = 333 * MiB;
constexpr size_t WS_KWT = 397 * MiB, WS_RVT = 413 * MiB, WS_FVT = 429 * MiB;
constexpr size_t WS_FKF = WS_AU + 32 * MiB;
constexpr size_t WS_UT = 461 * MiB, WS_PREV = 477 * MiB, WS_RKF = 485 * MiB, WS_WCS = 501 * MiB, WS_END = 509 * MiB;
static_assert(WS_WEND <= WS_H && WS_H + (size_t)M * D * 2 <= WS_BIG && WS_BIG + (size_t)M * NPROJ * 2 <= WS_AU && WS_AU + (size_t)M * 256 * 8 <= WS_KWT, "ws map");
constexpr int CW_BAR = 4096;
constexpr int CW_FOXK = 8192;
constexpr float FOX_T2 = 45.0f;

constexpr int RING_OFF = 0, RING_BYTES = 131072;
constexpr int LDSCTL_OFF = RING_BYTES, MISC_OFF = LDSCTL_OFF + 320;
constexpr int LDS_BYTES = 147456;
constexpr int LRU_TAB_OFF = 131072 + 512;

#define GAS __attribute__((address_space(1)))
#define LAS __attribute__((address_space(3)))
typedef unsigned short bf16;
typedef unsigned v4u __attribute__((ext_vector_type(4)));
typedef unsigned v2u __attribute__((ext_vector_type(2)));
typedef float f32x4 __attribute__((ext_vector_type(4)));
typedef float f32x16 __attribute__((ext_vector_type(16)));
typedef short bf16x8 __attribute__((ext_vector_type(8)));
typedef GAS unsigned gu32;
#define RLX_AGENT __ATOMIC_RELAXED, __HIP_MEMORY_SCOPE_AGENT
#define LDS_WAIT() asm volatile("s_waitcnt lgkmcnt(0)" ::: "memory")
#define VM_WAIT() asm volatile("s_waitcnt vmcnt(0)" ::: "memory")
#define MFMA32(a, b, c) __builtin_amdgcn_mfma_f32_32x32x16_bf16((a), (b), (c), 0, 0, 0)
__device__ __forceinline__ unsigned pk2(float lo, float hi) { return pg8::cvt_pk_bf16(lo, hi); }
__device__ __forceinline__ float bflo(unsigned w) { return __uint_as_float(w << 16); }
__device__ __forceinline__ float bfhi(unsigned w) { return __uint_as_float(w & 0xffff0000u); }
__device__ __forceinline__ int crow(int r, int hi) { return (r & 3) + 8 * (r >> 2) + 4 * hi; }
__device__ __forceinline__ int swap23(int r) { return (r & 0x13) | ((r & 4) << 1) | ((r & 8) >> 1); }
__device__ __forceinline__ bf16x8 ld8(const bf16* p) { return *(const bf16x8*)p; }
__device__ __forceinline__ bf16x8 pack8(const f32x16& x, int s) {
    v4u p; p.x = pk2(x[8 * s], x[8 * s + 1]); p.y = pk2(x[8 * s + 2], x[8 * s + 3]); p.z = pk2(x[8 * s + 4], x[8 * s + 5]); p.w = pk2(x[8 * s + 6], x[8 * s + 7]);
    return __builtin_bit_cast(bf16x8, p); }
__device__ __forceinline__ float wave_sum(float v) {
#pragma unroll
    for (int o = 1; o < 64; o <<= 1) v += __shfl_xor(v, o);
    return v;
}
__device__ __forceinline__ float sigmoidf_(float x) { return __builtin_amdgcn_rcpf(1.0f + __builtin_amdgcn_exp2f(-LOG2E * x)); }
__device__ __forceinline__ float lg2gamma(int h) { return h == 0 ? -0.04580368961312479f : h == 1 ? -0.02272007650008353f : h == 2 ? -0.011315313227834146f : -0.005646563141142063f; }

#define XB_TMO      128
#define XB_XCNT(j)  (256  + 64 * (j))
#define XB_XSUB(j)  (1280 + 64 * (j))
#define XB_XGEN(j)  (2304 + 64 * (j))
#define XB_TOP      3328
#define XB_TOPGEN   3392
#define XCD_BAR_WORDS 3456
#define XB_SPIN_CAP (1u << 18)

__device__ __forceinline__ unsigned xb_ld(unsigned* p)              { return __hip_atomic_load(p, __ATOMIC_RELAXED, __HIP_MEMORY_SCOPE_AGENT); }
__device__ __forceinline__ unsigned xb_add(unsigned* p, unsigned v) { return __hip_atomic_fetch_add(p, v, __ATOMIC_RELAXED, __HIP_MEMORY_SCOPE_AGENT); }
__device__ __forceinline__ unsigned xb_xcc_id() { return (unsigned)__builtin_amdgcn_s_getreg((3 << 11) | 20) & 0xFu; }
#define XB_SPIN(cond, bar) do { unsigned _sp = 0; while (cond) { __builtin_amdgcn_s_sleep(1); \
    if ((++_sp & 255u) == 0u) { if (xb_ld(&(bar)[XB_TMO])) break; if (_sp > XB_SPIN_CAP) { atomicAdd(&(bar)[XB_TMO], 1u); break; } } } } while (0)

struct XcdBarrier {
    unsigned* bar; unsigned x;
    volatile LAS unsigned* st;
};

__device__ __forceinline__ XcdBarrier xcd_barrier_post(unsigned* bar, volatile LAS unsigned* st) {
    XcdBarrier b; b.bar = bar; b.x = xb_xcc_id(); b.st = st;
    if (threadIdx.x == 0) (void)xb_add(&bar[XB_XCNT(b.x)], 1u);
    return b;
}
__device__ __forceinline__ void xcd_barrier_complete(unsigned* bar, unsigned x, unsigned& nloc, unsigned& nx) {
    const unsigned G = gridDim.x * gridDim.y * gridDim.z;
    unsigned sum, cnt, mine, sp = 0u;
    for (;;) {
        sum = 0u; cnt = 0u; mine = 0u;
#pragma unroll
        for (unsigned j = 0; j < 16; ++j) { const unsigned c = xb_ld(&bar[XB_XCNT(j)]); sum += c; cnt += (c > 0u) ? 1u : 0u; mine = (j == x) ? c : mine; }
        if (sum == G) break;
        __builtin_amdgcn_s_sleep(1);
        if ((++sp & 255u) == 0u) { if (xb_ld(&bar[XB_TMO])) break; if (sp > XB_SPIN_CAP) { atomicAdd(&bar[XB_TMO], 1u); break; } }
    }
    nloc = mine > 0u ? mine : 1u; nx = cnt > 0u ? cnt : 1u;
}

__device__ __forceinline__ void xcd_barrier(const XcdBarrier& b) {
    asm volatile("s_waitcnt vmcnt(0)" ::: "memory");
    __syncthreads();
    if (threadIdx.x == 0) {
        unsigned* bar = b.bar;
        __builtin_amdgcn_s_waitcnt(0);
        unsigned nloc = b.st[0], nx = b.st[1];
        if (nloc == 0u) { xcd_barrier_complete(bar, b.x, nloc, nx); b.st[0] = nloc; b.st[1] = nx; }
        const unsigned old = xb_add(&bar[XB_XSUB(b.x)], 1u);
        const unsigned gen = old / nloc;
        if (old + 1u == (gen + 1u) * nloc) {
            __builtin_amdgcn_fence(__ATOMIC_RELEASE, "agent");
            asm volatile("s_waitcnt vmcnt(0)" ::: "memory");
            const unsigned og = xb_add(&bar[XB_TOP], 1u);
            const unsigned tg = og / nx;
            if (og + 1u == (tg + 1u) * nx) xb_add(&bar[XB_TOPGEN], 1u);
            else XB_SPIN(xb_ld(&bar[XB_TOPGEN]) == tg, bar);
            __builtin_amdgcn_fence(__ATOMIC_ACQUIRE, "agent");
            xb_add(&bar[XB_XGEN(b.x)], 1u);
            asm volatile("s_waitcnt vmcnt(0)" ::: "memory");
        } else {
            XB_SPIN(xb_ld(&bar[XB_XGEN(b.x)]) == gen, bar);
            __builtin_amdgcn_fence(__ATOMIC_ACQUIRE, "agent");
            asm volatile("s_waitcnt vmcnt(0)" ::: "memory");
        }
    }
    __syncthreads();
}

struct Args { const float* in[27]; float* out; unsigned char* ws; };
struct Frame {
    LAS unsigned char* lds;
    volatile LAS unsigned* MISC;
    gu32* ctl;
    int tid, lane, wave;
    int G, gw, NGW;
    unsigned char* ws;
};

__device__ __forceinline__ void transpose_item(const float* W, int ldw, int k0, int n0, bf16* WT, int K, int dn0, LAS float* scr, int lane, const float* gain) {
    float wv[32];
#pragma unroll
    for (int i = 0; i < 32; ++i) wv[i] = W[(size_t)(k0 + 2 * i + (lane >> 5)) * ldw + n0 + (lane & 31)];
#pragma unroll
    for (int i = 0; i < 32; ++i) { const int kk = 2 * i + (lane >> 5); const float g = gain ? gain[k0 + kk] : 1.0f; scr[kk * 33 + (lane & 31)] = g * wv[i]; }
    LDS_WAIT(); asm volatile("" ::: "memory");
    const int c = lane & 7;
#pragma unroll
    for (int j = 0; j < 4; ++j) { const int n = (lane >> 3) + 8 * j; const LAS float* s = scr + (8 * c) * 33 + n;
        v4u o; o.x = pk2(s[0 * 33], s[1 * 33]); o.y = pk2(s[2 * 33], s[3 * 33]); o.z = pk2(s[4 * 33], s[5 * 33]); o.w = pk2(s[6 * 33], s[7 * 33]);
        *(GAS v4u*)(WT + (size_t)(dn0 + n) * K + k0 + 8 * c) = o; }
    LDS_WAIT(); asm volatile("" ::: "memory");
}
__device__ __forceinline__ int conv_matrix(Frame& F, LAS float* scr, int it0, int it, const float* W, int ldw, int K, int csrc0, int ncols, bf16* WT, int drow0, int mode, const float* gain) {
    const int nblk = ncols / 32, nitems = (K / 64) * nblk;
    const int r = it - it0;
    if (r >= 0 && r < nitems) {
        const int kb = r / nblk, nb = r % nblk; int n0 = csrc0 + 32 * nb, dn0;
        if (mode == 0) dn0 = drow0 + 32 * nb;
        else if (mode == 1) { dn0 = 32 * nb; const int t = dn0 >> 8;
            const int st = t == 0 ? 256 : t == 1 ? 512 : t == 2 ? 768 : t == 3 ? 2056 : t == 4 ? 2824 : t == 5 ? 0 : t == 6 ? 2312 : t == 7 ? 1024 : t == 8 ? 1280 : t == 9 ? 1536 : t == 10 ? 1792 : 2568;
            n0 = st + (dn0 & 255); }
        else { const int j = 32 * nb; dn0 = 256 * (j / 128) + 128 * (mode - 2) + (j % 128); }
        transpose_item(W, ldw, 64 * kb, n0, WT, K, dn0, scr, F.lane, gain);
    }
    return it0 + nitems;
}

template <int MODE, bool HAS_FF>
__device__ __forceinline__ void thin_pass(Frame& F, const bf16* raw, const float* xin, bf16* xb, float* out, const float* gpost, float* rstd, const float* gpre,
                                          const float* win_l  , const float* bfox, float* lfT) {
    LAS float* wfT = (LAS float*)(F.lds + RING_OFF);
    if (HAS_FF) {
        for (int k = F.tid; k < D; k += NWAVES * 64) { const f32x4 a = *(const f32x4*)(win_l + (size_t)k * INW + 2048), b = *(const f32x4*)(win_l + (size_t)k * INW + 2052);
            wfT[0 * D + k] = a[0]; wfT[1 * D + k] = a[1]; wfT[2 * D + k] = a[2]; wfT[3 * D + k] = a[3]; wfT[4 * D + k] = b[0]; wfT[5 * D + k] = b[1]; wfT[6 * D + k] = b[2]; wfT[7 * D + k] = b[3]; }
        __syncthreads();
    }
    f32x4 gp[4], gq[4];
#pragma unroll
    for (int j = 0; j < 4; ++j) { gp[j] = MODE >= 1 ? *(const f32x4*)(gpost + 4 * F.lane + 256 * j) : (f32x4){0.f, 0.f, 0.f, 0.f}; gq[j] = HAS_FF ? *(const f32x4*)(gpre + 4 * F.lane + 256 * j) : (f32x4){0.f, 0.f, 0.f, 0.f}; }
    for (int row = F.gw; row < M; row += F.NGW) {
        f32x4 x[4];
        if (MODE == 0) {
#pragma unroll
            for (int j = 0; j < 4; ++j) x[j] = *(const f32x4*)(xin + (size_t)row * D + 4 * F.lane + 256 * j);
        } else {
            f32x4 rw[4]; float ss = 0.f;
#pragma unroll
            for (int j = 0; j < 4; ++j) { const v2u w = *(const v2u*)(raw + (size_t)row * D + 4 * F.lane + 256 * j), wx = *(const v2u*)(xb + (size_t)row * D + 4 * F.lane + 256 * j);
                rw[j] = (f32x4){bflo(w.x), bfhi(w.x), bflo(w.y), bfhi(w.y)}; x[j] = (f32x4){bflo(wx.x), bfhi(wx.x), bflo(wx.y), bfhi(wx.y)};
                ss += (rw[j][0] * rw[j][0] + rw[j][1] * rw[j][1]) + (rw[j][2] * rw[j][2] + rw[j][3] * rw[j][3]); }
            const float rstd1 = 1.0f / sqrtf(wave_sum(ss) * (1.0f / D) + EPS);
#pragma unroll
            for (int j = 0; j < 4; ++j) x[j] = x[j] + rw[j] * rstd1 * gp[j];
        }
        if (MODE == 2) {
#pragma unroll
            for (int j = 0; j < 4; ++j) *(f32x4*)(out + (size_t)row * D + 4 * F.lane + 256 * j) = x[j];
        } else {
            float ss = 0.f;
#pragma unroll
            for (int j = 0; j < 4; ++j) { v2u w; w.x = pk2(x[j][0], x[j][1]); w.y = pk2(x[j][2], x[j][3]); *(v2u*)(xb + (size_t)row * D + 4 * F.lane + 256 * j) = w;
                x[j] = (f32x4){bflo(w.x), bfhi(w.x), bflo(w.y), bfhi(w.y)};
                ss += (x[j][0] * x[j][0] + x[j][1] * x[j][1]) + (x[j][2] * x[j][2] + x[j][3] * x[j][3]); }
            const float rs2 = 1.0f / sqrtf(wave_sum(ss) * (1.0f / D) + EPS);
            if (F.lane == 0) rstd[row] = rs2;
            if (HAS_FF) {
                float ff[8];
#pragma unroll
                for (int j = 0; j < 4; ++j) x[j] = x[j] * rs2 * gq[j];
#pragma unroll
                for (int q = 0; q < 8; ++q) { float a = 0.f;
#pragma unroll
                    for (int j = 0; j < 4; ++j) { const f32x4 w = *(const LAS f32x4*)(wfT + q * D + 4 * F.lane + 256 * j); a += (x[j][0] * w[0] + x[j][1] * w[1]) + (x[j][2] * w[2] + x[j][3] * w[3]); }
                    ff[q] = wave_sum(a); }
                float mine = 0.f;
#pragma unroll
                for (int q = 0; q < 8; ++q) if (F.lane == q) mine = ff[q];
                if (F.lane < 8) { const float z = mine + bfox[F.lane]; const float lf = fminf(z, 0.f) - log1pf(expf(-fabsf(z)));
                    const int b = row / SEQ, t = row % SEQ; lfT[((size_t)b * 8 + F.lane) * SEQ + t] = lf; }
            }
        }
    }
}

template <int MODE>
__device__ __forceinline__ void thin4(Frame& F, const bf16* raw, const bf16* xb, bf16* xo, float* out, const float* gpost, float* rstd, const int rbeg, const int rend, const int gwl, const int ngw) {
    f32x4 gp[2][2];
#pragma unroll
    for (int s = 0; s < 2; ++s)
#pragma unroll
        for (int h = 0; h < 2; ++h) gp[s][h] = *(const f32x4*)(gpost + 512 * s + 8 * F.lane + 4 * h);
    for (int row0 = rbeg + gwl; row0 < rend; row0 += 4 * ngw) {
        v4u rw[4][2], xw[4][2];
#pragma unroll
        for (int r = 0; r < 4; ++r)
#pragma unroll
            for (int s = 0; s < 2; ++s) { const size_t o = (size_t)(row0 + r * ngw) * D + 512 * s + 8 * F.lane; rw[r][s] = *(const v4u*)(raw + o); xw[r][s] = *(const v4u*)(xb + o); }
        float ss[4];
#pragma unroll
        for (int r = 0; r < 4; ++r) { float a = 0.f;
#pragma unroll
            for (int s = 0; s < 2; ++s) { const v4u w = rw[r][s];
                a += ((bflo(w.x) * bflo(w.x) + bfhi(w.x) * bfhi(w.x)) + (bflo(w.y) * bflo(w.y) + bfhi(w.y) * bfhi(w.y))) + ((bflo(w.z) * bflo(w.z) + bfhi(w.z) * bfhi(w.z)) + (bflo(w.w) * bflo(w.w) + bfhi(w.w) * bfhi(w.w))); }
            ss[r] = a; }
#pragma unroll
        for (int o = 1; o < 64; o <<= 1)
#pragma unroll
            for (int r = 0; r < 4; ++r) ss[r] += __shfl_xor(ss[r], o);
        float s2[4];
#pragma unroll
        for (int r = 0; r < 4; ++r) { const float rs1 = 1.0f / sqrtf(ss[r] * (1.0f / D) + EPS); float a = 0.f; const size_t ro = (size_t)(row0 + r * ngw) * D;
#pragma unroll
            for (int s = 0; s < 2; ++s) { const v4u w = rw[r][s], wx = xw[r][s];
                const f32x4 y0 = (f32x4){bflo(wx.x), bfhi(wx.x), bflo(wx.y), bfhi(wx.y)} + (f32x4){bflo(w.x), bfhi(w.x), bflo(w.y), bfhi(w.y)} * rs1 * gp[s][0];
                const f32x4 y1 = (f32x4){bflo(wx.z), bfhi(wx.z), bflo(wx.w), bfhi(wx.w)} + (f32x4){bflo(w.z), bfhi(w.z), bflo(w.w), bfhi(w.w)} * rs1 * gp[s][1];
                if (MODE == 2) { *(f32x4*)(out + ro + 512 * s + 8 * F.lane) = y0; *(f32x4*)(out + ro + 512 * s + 8 * F.lane + 4) = y1; }
                else { v4u q; q.x = pk2(y0[0], y0[1]); q.y = pk2(y0[2], y0[3]); q.z = pk2(y1[0], y1[1]); q.w = pk2(y1[2], y1[3]); *(v4u*)(xo + ro + 512 * s + 8 * F.lane) = q;
                    a += ((bflo(q.x) * bflo(q.x) + bfhi(q.x) * bfhi(q.x)) + (bflo(q.y) * bflo(q.y) + bfhi(q.y) * bfhi(q.y))) + ((bflo(q.z) * bflo(q.z) + bfhi(q.z) * bfhi(q.z)) + (bflo(q.w) * bflo(q.w) + bfhi(q.w) * bfhi(q.w))); } }
            s2[r] = a; }
        if (MODE != 2) {
#pragma unroll
            for (int o = 1; o < 64; o <<= 1)
#pragma unroll
                for (int r = 0; r < 4; ++r) s2[r] += __shfl_xor(s2[r], o);
#pragma unroll
            for (int r = 0; r < 4; ++r) if (F.lane == r) rstd[row0 + r * ngw] = 1.0f / sqrtf(s2[r] * (1.0f / D) + EPS);
        }
    }
}

__device__ __forceinline__ void cscan_job(Frame& F, const float* lfT, float* c2, int bh) {
    LAS double* tot = (LAS double*)(F.lds + RING_OFF);
    const float* src = lfT + (size_t)bh * SEQ + 32 * F.tid; float* dst = c2 + (size_t)bh * SEQ + 32 * F.tid;
    float v[32];
#pragma unroll
    for (int j = 0; j < 8; ++j) { const f32x4 a = *(const f32x4*)(src + 4 * j); v[4 * j] = a[0]; v[4 * j + 1] = a[1]; v[4 * j + 2] = a[2]; v[4 * j + 3] = a[3]; }
#pragma unroll
    for (int j = 1; j < 32; ++j) v[j] += v[j - 1];
    double incl = (double)v[31];
#pragma unroll
    for (int o = 1; o < 64; o <<= 1) { const double t = __shfl_up(incl, o); if (F.lane >= o) incl += t; }
    if (F.lane == 63) tot[F.wave] = incl;
    __syncthreads();
    double off = incl - (double)v[31];
    for (int w = 0; w < F.wave; ++w) off += tot[w];
#pragma unroll
    for (int j = 0; j < 8; ++j) { f32x4 o; o[0] = (float)((off + (double)v[4 * j]) * 1.4426950408889634); o[1] = (float)((off + (double)v[4 * j + 1]) * 1.4426950408889634);
        o[2] = (float)((off + (double)v[4 * j + 2]) * 1.4426950408889634); o[3] = (float)((off + (double)v[4 * j + 3]) * 1.4426950408889634); *(f32x4*)(dst + 4 * j) = o; }
    __syncthreads();
}

__device__ __forceinline__ void lru_block_unit(Frame& F, int tile, int blk, const bf16* proj, const bf16* wgf  , bf16* ACout, bf16* HLout, float* carA, float* carH) {
    const LAS float* tab = (const LAS float*)(F.lds + LRU_TAB_OFF) + blk * 512;
    LAS unsigned char* X = F.lds + RING_OFF + F.wave * 16384;
    LAS unsigned char* TA = X + 5056; LAS unsigned char* TH = TA + 4608;
    const int r = F.lane & 31, h2 = F.lane >> 5;
    const int m0 = tile * 32, tl0 = m0 % SEQ;
#pragma unroll
    for (int i = 0; i < 5; ++i) { const int idx = F.lane + 64 * i, row = idx >> 3, chn = idx & 7;
        if (row < 35) { v4u v = (v4u){0u, 0u, 0u, 0u}; if (tl0 - 3 + row >= 0) v = *(const v4u*)(proj + (size_t)(m0 - 3 + row) * PTN + T_LX + 64 * blk + 8 * chn); *(LAS v4u*)(X + row * 144 + chn * 16) = v; } }
    LDS_WAIT(); asm volatile("" ::: "memory");
    bf16x8 xcf[4];
#pragma unroll
    for (int s = 0; s < 4; ++s) {
        const int cl = 16 * s + 8 * h2, cb = 64 * blk + cl;
        float xc[8];
        { const f32x4 b0 = *(const LAS f32x4*)(tab + 4 * 64 + cl), b1 = *(const LAS f32x4*)(tab + 4 * 64 + cl + 4); xc[0] = b0[0]; xc[1] = b0[1]; xc[2] = b0[2]; xc[3] = b0[3]; xc[4] = b1[0]; xc[5] = b1[1]; xc[6] = b1[2]; xc[7] = b1[3]; }
#pragma unroll
        for (int k = 0; k < 4; ++k) {
            const v4u w = *(const LAS v4u*)(X + (r + k) * 144 + cl * 2);
            const f32x4 c0 = *(const LAS f32x4*)(tab + k * 64 + cl), c1 = *(const LAS f32x4*)(tab + k * 64 + cl + 4);
            xc[0] += c0[0] * bflo(w.x); xc[1] += c0[1] * bfhi(w.x); xc[2] += c0[2] * bflo(w.y); xc[3] += c0[3] * bfhi(w.y);
            xc[4] += c1[0] * bflo(w.z); xc[5] += c1[1] * bfhi(w.z); xc[6] += c1[2] * bflo(w.w); xc[7] += c1[3] * bfhi(w.w);
        }
        v4u p; p.x = pk2(xc[0], xc[1]); p.y = pk2(xc[2], xc[3]); p.z = pk2(xc[4], xc[5]); p.w = pk2(xc[6], xc[7]);
        xcf[s] = __builtin_bit_cast(bf16x8, p);
    }
    f32x16 Gr[2], Gi[2];
#pragma unroll
    for (int jt = 0; jt < 2; ++jt) { Gr[jt] = (f32x16){}; Gi[jt] = (f32x16){}; }
#pragma unroll
    for (int jt = 0; jt < 2; ++jt)
#pragma unroll
        for (int s = 0; s < 4; ++s) {
            const bf16x8 wr_ = ld8(wgf + ((size_t)(((0 * 4 + blk) * 2 + jt) * 4 + s) * 64 + F.lane) * 8);
            const bf16x8 wi_ = ld8(wgf + ((size_t)(((1 * 4 + blk) * 2 + jt) * 4 + s) * 64 + F.lane) * 8);
            Gr[jt] = MFMA32(xcf[s], wr_, Gr[jt]); Gi[jt] = MFMA32(xcf[s], wi_, Gi[jt]);
        }
#pragma unroll
    for (int jt = 0; jt < 2; ++jt) {
        const int cl = 32 * jt + r, ch = 64 * blk + cl;
        const float cw0 = tab[0 * 64 + cl], cw1 = tab[1 * 64 + cl], cw2 = tab[2 * 64 + cl], cw3 = tab[3 * 64 + cl], cbias = tab[4 * 64 + cl], br = tab[5 * 64 + cl], bi = tab[6 * 64 + cl], s8 = tab[7 * 64 + cl];
        float aa[16], hh[16];
#pragma unroll
        for (int g = 0; g < 4; ++g) {
            const int t0 = 8 * g + 4 * h2;
            float xr[7];
#pragma unroll
            for (int j = 0; j < 7; ++j) xr[j] = bflo((unsigned)*(const LAS unsigned short*)(X + (t0 + j) * 144 + cl * 2));
#pragma unroll
            for (int i = 0; i < 4; ++i) {
                const float xc = cbias + cw0 * xr[i] + cw1 * xr[i + 1] + cw2 * xr[i + 2] + cw3 * xr[i + 3];
                const float rg = sigmoidf_(Gr[jt][4 * g + i] + br), ig = sigmoidf_(Gi[jt][4 * g + i] + bi);
                const float la = -rg * s8; const float a = __builtin_amdgcn_exp2f(LOG2E * la);
                aa[4 * g + i] = a; hh[4 * g + i] = sqrtf(fmaxf(fmaf(-a, a, 1.0f), 0.f)) * (ig * xc);
            }
#pragma unroll
            for (int i = 1; i < 4; ++i) { hh[4 * g + i] = aa[4 * g + i] * hh[4 * g + i - 1] + hh[4 * g + i]; aa[4 * g + i] = aa[4 * g + i] * aa[4 * g + i - 1]; }
        }
        float cA = 1.0f, cH = 0.f, inA[4], inH[4];
#pragma unroll
        for (int sg = 0; sg < 8; ++sg) {
            const int g = sg >> 1; const bool mine = (h2 == (sg & 1));
            if (mine) { inA[g] = cA; inH[g] = cH; }
            const float eA = aa[4 * g + 3] * cA, eH = aa[4 * g + 3] * cH + hh[4 * g + 3];
            const float pA = __shfl_xor(eA, 32), pH = __shfl_xor(eH, 32);
            if (!mine) { cA = pA; cH = pH; }
            if (sg == 7 && h2 == 1) { carA[(size_t)tile * 256 + ch] = eA; carH[(size_t)tile * 256 + ch] = eH; }
        }
#pragma unroll
        for (int reg = 0; reg < 16; ++reg) { const int g = reg >> 2, t = (reg & 3) + 8 * g + 4 * h2;
            const float hf = hh[reg] + aa[reg] * inH[g], af = aa[reg] * inA[g];
            *(LAS unsigned short*)(TA + t * 144 + cl * 2) = (unsigned short)(pk2(af, 0.f) & 0xffffu); *(LAS unsigned short*)(TH + t * 144 + cl * 2) = (unsigned short)(pk2(hf, 0.f) & 0xffffu); }
    }
    LDS_WAIT(); asm volatile("" ::: "memory");
#pragma unroll
    for (int i = 0; i < 4; ++i) { const int idx = F.lane + 64 * i, row = idx >> 3, chn = idx & 7;
        const v4u va = *(const LAS v4u*)(TA + row * 144 + chn * 16), vh = *(const LAS v4u*)(TH + row * 144 + chn * 16);
        *(v4u*)(ACout + (size_t)(m0 + row) * 256 + 64 * blk + 8 * chn) = va; *(v4u*)(HLout + (size_t)(m0 + row) * 256 + 64 * blk + 8 * chn) = vh; }
    LDS_WAIT(); asm volatile("" ::: "memory");
}

__device__ __forceinline__ float invfreq(int c, int e) {
    const float t[32] = {1.0f, 0.7498942017555237f, 0.5623413324356079f, 0.4216965138912201f, 0.3162277638912201f, 0.23713737726211548f, 0.17782793939113617f, 0.1333521455526352f,
        0.10000000149011612f, 0.0749894231557846f, 0.05623413249850273f, 0.04216964915394783f, 0.03162277489900589f, 0.023713737726211548f, 0.017782794311642647f, 0.013335213996469975f,
        0.009999999776482582f, 0.007498942315578461f, 0.005623413249850273f, 0.0042169648222625256f, 0.003162277629598975f, 0.0023713738191872835f, 0.0017782794311642647f, 0.0013335214462131262f,
        0.0010000000474974513f, 0.0007498941849917173f, 0.000562341301701963f, 0.0004216965171508491f, 0.0003162277571391314f, 0.00023713737027719617f, 0.00017782794020604342f, 0.0001333521504420787f};
    return c == 0 ? t[e] : c == 1 ? t[8 + e] : c == 2 ? t[16 + e] : t[24 + e];
}
__device__ __forceinline__ void prep_load(Frame& F, int tt, int jb, const bf16* pk, const bf16* pt, v4u (&w)[8]) {
    const int m0 = 64 * tt;
    if (jb < 8) {
        const int rr = F.lane >> 2, c = F.lane & 3; int scol, pitch = PTN; const bf16* proj = pt;
        if (jb < 4) { scol = K_RQ + 64 * jb; proj = pk; pitch = PKN; } else scol = T_RK + 64 * (jb - 4);
#pragma unroll
        for (int it = 0; it < 4; ++it) { const bf16* p = proj + (size_t)(m0 + 16 * it + rr) * pitch + scol + 8 * c; w[2 * it] = *(const v4u*)p; w[2 * it + 1] = *(const v4u*)(p + 32); }
    }
}
__device__ __forceinline__ void prep_unit(Frame& F, int tt, int jb, bf16* pk, const bf16* pt, const int* positions, bf16* rkf, bf16* kwf, bf16* rvf, bf16* fvT, const v4u (&wl)[8]) {
    LAS bf16* T = (LAS bf16*)(F.lds + RING_OFF + F.wave * 16384);
    const int m0 = 64 * tt, rr = F.lane >> 2, c = F.lane & 3;
    const int b_ = m0 / SEQ, t0 = (m0 % SEQ) / 32;
    int scol, h, pitch = PTN; bf16* proj = const_cast<bf16*>(pt);
    if (jb < 4) { h = jb; scol = K_RQ + 64 * h; proj = pk; pitch = PKN; }
    else { h = jb - 4; scol = T_RK + 64 * h; }
    const bool rot = jb < 8, isk = (jb >= 4 && jb < 8);
    const float lgk = lg2gamma(h);
#pragma unroll
    for (int it = 0; it < 4; ++it) {
        const int row = 16 * it + rr, m = m0 + row;
        bf16* p = proj + (size_t)m * pitch + scol + 8 * c;
        const v4u w1 = wl[2 * it], w2 = wl[2 * it + 1];
        float x1[8] = {bflo(w1.x), bfhi(w1.x), bflo(w1.y), bfhi(w1.y), bflo(w1.z), bfhi(w1.z), bflo(w1.w), bfhi(w1.w)};
        float x2[8] = {bflo(w2.x), bfhi(w2.x), bflo(w2.y), bfhi(w2.y), bflo(w2.z), bfhi(w2.z), bflo(w2.w), bfhi(w2.w)};
        float wt = 1.0f;
        if (rot) {
            const float pos = (float)positions[m];
#pragma unroll
            for (int e = 0; e < 8; ++e) {
                const float ang = pos * invfreq(c, e);
                const double rev = (double)ang * 0.15915494309189535; const float fr = (float)(rev - __builtin_rint(rev));
                const float sn = __builtin_amdgcn_sinf(fr), cs = __builtin_amdgcn_cosf(fr);
                const float a = x1[e], b = x2[e]; x1[e] = a * cs - b * sn; x2[e] = a * sn + b * cs;
            }
            if (isk) {
#pragma unroll
                for (int e = 0; e < 8; ++e) { x1[e] *= 0.125f; x2[e] *= 0.125f; }
                wt = __builtin_amdgcn_exp2f((float)(127 - (m & 127)) * lgk);
            }
            v4u o1, o2; o1.x = pk2(x1[0], x1[1]); o1.y = pk2(x1[2], x1[3]); o1.z = pk2(x1[4], x1[5]); o1.w = pk2(x1[6], x1[7]);
            o2.x = pk2(x2[0], x2[1]); o2.y = pk2(x2[2], x2[3]); o2.z = pk2(x2[4], x2[5]); o2.w = pk2(x2[6], x2[7]);
            if (!isk) { *(v4u*)p = o1; *(v4u*)(p + 32) = o2; }
            else {
                const int rl = swap23(row & 31); bf16* kb_ = rkf + ((size_t)((b_ * 4 + h) * 512 + t0 + (row >> 5)) * 4) * 512;
                *(v4u*)(kb_ + (size_t)((c >> 1) * 64 + rl + 32 * (c & 1)) * 8) = o1;
                *(v4u*)(kb_ + (size_t)((2 + (c >> 1)) * 64 + rl + 32 * (c & 1)) * 8) = o2;
            }
        }
        if (jb >= 4) {
#pragma unroll
            for (int e = 0; e < 8; ++e) { T[(8 * c + e) * 72 + row] = (bf16)(pk2(x1[e] * wt, 0.f) & 0xffffu); T[(32 + 8 * c + e) * 72 + row] = (bf16)(pk2(x2[e] * wt, 0.f) & 0xffffu); }
        }
    }
    if (jb >= 4) {
        LDS_WAIT(); asm volatile("" ::: "memory");
        const int r_ = F.lane & 31, h2_ = F.lane >> 5;
        if (jb >= 12) {
            bf16* vfb = fvT + ((size_t)((b_ * 8 + h) * 512 + t0) * 4) * 512 + F.lane * 8;
#pragma unroll
            for (int ti = 0; ti < 2; ++ti)
#pragma unroll
                for (int f = 0; f < 4; ++f) { const v4u v = *(const LAS v4u*)(T + (32 * (f >> 1) + r_) * 72 + 32 * ti + 16 * (f & 1) + 8 * h2_); *(v4u*)(vfb + (size_t)(ti * 4 + f) * 512) = v; }
        } else {
            const int n = t0 >> 2, half = (t0 >> 1) & 1;
            bf16* dst = (jb < 8 ? kwf : rvf) + ((size_t)((b_ * 128 + n) * 4 + h) * 16) * 512 + F.lane * 8;
#pragma unroll
            for (int xt = 0; xt < 2; ++xt)
#pragma unroll
                for (int sl = 0; sl < 4; ++sl) { const v4u v = *(const LAS v4u*)(T + (32 * xt + r_) * 72 + 16 * sl + 8 * h2_); *(v4u*)(dst + (size_t)(xt * 8 + 4 * half + sl) * 512) = v; }
        }
        LDS_WAIT(); asm volatile("" ::: "memory");
    }
}

__device__ __forceinline__ void kchunk_unit(Frame& F, int unit, const bf16* pt, const int* positions, bf16* rkf, const bf16* rvf, float* UT) {
    LAS bf16* T = (LAS bf16*)(F.lds + RING_OFF + F.wave * 16384);
    const int h = unit & 3, bn = unit >> 2, b_ = bn >> 7, n = bn & 127;
    const int rr = F.lane >> 2, c = F.lane & 3, r = F.lane & 31, h2 = F.lane >> 5;
    const float lgk = lg2gamma(h);
    f32x16 acc[2][2];
#pragma unroll
    for (int i = 0; i < 2; ++i)
#pragma unroll
        for (int j = 0; j < 2; ++j) acc[i][j] = (f32x16){};
#pragma unroll 1
    for (int half = 0; half < 2; ++half) {
        const int m0 = bn * 128 + 64 * half, t0 = 4 * n + 2 * half;
        v4u wl[1][8];
#pragma unroll
        for (int it = 0; it < 4; ++it) { const bf16* p = pt + (size_t)(m0 + 16 * it + rr) * PTN + T_RK + 64 * h + 8 * c; wl[0][2 * it] = *(const v4u*)p; wl[0][2 * it + 1] = *(const v4u*)(p + 32); }
#pragma unroll
        for (int it = 0; it < 4; ++it) {
            const int row = 16 * it + rr, m = m0 + row;
            const v4u w1 = wl[0][2 * it], w2 = wl[0][2 * it + 1];
            float x1[8] = {bflo(w1.x), bfhi(w1.x), bflo(w1.y), bfhi(w1.y), bflo(w1.z), bfhi(w1.z), bflo(w1.w), bfhi(w1.w)};
            float x2[8] = {bflo(w2.x), bfhi(w2.x), bflo(w2.y), bfhi(w2.y), bflo(w2.z), bfhi(w2.z), bflo(w2.w), bfhi(w2.w)};
            const float pos = (float)positions[m];
#pragma unroll
            for (int e = 0; e < 8; ++e) {
                const float ang = pos * invfreq(c, e);
                const double rev = (double)ang * 0.15915494309189535; const float fr = (float)(rev - __builtin_rint(rev));
                const float sn = __builtin_amdgcn_sinf(fr), cs = __builtin_amdgcn_cosf(fr);
                const float a = x1[e], bb = x2[e]; x1[e] = (a * cs - bb * sn) * 0.125f; x2[e] = (a * sn + bb * cs) * 0.125f;
            }
            const float wt = __builtin_amdgcn_exp2f((float)(127 - (m & 127)) * lgk);
            v4u o1, o2; o1.x = pk2(x1[0], x1[1]); o1.y = pk2(x1[2], x1[3]); o1.z = pk2(x1[4], x1[5]); o1.w = pk2(x1[6], x1[7]);
            o2.x = pk2(x2[0], x2[1]); o2.y = pk2(x2[2], x2[3]); o2.z = pk2(x2[4], x2[5]); o2.w = pk2(x2[6], x2[7]);
            const int rl = swap23(row & 31); bf16* kb_ = rkf + ((size_t)((b_ * 4 + h) * 512 + t0 + (row >> 5)) * 4) * 512;
            *(v4u*)(kb_ + (size_t)((c >> 1) * 64 + rl + 32 * (c & 1)) * 8) = o1;
            *(v4u*)(kb_ + (size_t)((2 + (c >> 1)) * 64 + rl + 32 * (c & 1)) * 8) = o2;
#pragma unroll
            for (int e = 0; e < 8; ++e) { T[(8 * c + e) * 72 + row] = (bf16)(pk2(x1[e] * wt, 0.f) & 0xffffu); T[(32 + 8 * c + e) * 72 + row] = (bf16)(pk2(x2[e] * wt, 0.f) & 0xffffu); }
        }
        LDS_WAIT(); asm volatile("" ::: "memory");
#pragma unroll
        for (int sl = 0; sl < 4; ++sl) {
            bf16x8 af[2], bfr[2];
#pragma unroll
            for (int i = 0; i < 2; ++i) { af[i] = ld8(rvf + ((size_t)(unit * 2 + i) * 8 + 4 * half + sl) * 512 + F.lane * 8); bfr[i] = *(const LAS bf16x8*)(T + (32 * i + r) * 72 + 16 * sl + 8 * h2); }
#pragma unroll
            for (int et = 0; et < 2; ++et)
#pragma unroll
                for (int dt = 0; dt < 2; ++dt) acc[et][dt] = MFMA32(af[et], bfr[dt], acc[et][dt]);
        }
        LDS_WAIT(); asm volatile("" ::: "memory");
    }
    float* dst = UT + (size_t)unit * 4096;
#pragma unroll
    for (int et = 0; et < 2; ++et)
#pragma unroll
        for (int dt = 0; dt < 2; ++dt)
#pragma unroll
            for (int reg = 0; reg < 16; ++reg) dst[(32 * et + crow(reg, h2)) * 64 + 32 * dt + r] = acc[et][dt][reg];
}

__device__ __forceinline__ void fox_knorm_load(Frame& F, const bf16* kfr, v4u (&kn)[16]) {
#pragma unroll
    for (int k = 0; k < 4; ++k) { const int j = 32 * (int)blockIdx.x + 4 * F.wave + k; const bf16* src = kfr + (size_t)j * 4 * 512 + F.lane * 8;
#pragma unroll
        for (int s_ = 0; s_ < 4; ++s_) kn[4 * k + s_] = *(const v4u*)(src + (size_t)s_ * 512); }
}
__device__ __forceinline__ void fox_knorm_reduce(Frame& F, const v4u (&kn)[16], unsigned* kmax  ) {
    LAS float* red = (LAS float*)(F.lds + RING_OFF + 1024);
    float mx = 0.f;
#pragma unroll
    for (int k = 0; k < 4; ++k) { float sq = 0.f;
#pragma unroll
        for (int s_ = 0; s_ < 4; ++s_) { const v4u v = kn[4 * k + s_];
            sq += bflo(v.x) * bflo(v.x) + bfhi(v.x) * bfhi(v.x) + bflo(v.y) * bflo(v.y) + bfhi(v.y) * bfhi(v.y) + bflo(v.z) * bflo(v.z) + bfhi(v.z) * bfhi(v.z) + bflo(v.w) * bflo(v.w) + bfhi(v.w) * bfhi(v.w); }
        sq += __shfl_xor(sq, 32); mx = fmaxf(mx, sq); }
#pragma unroll
    for (int o = 1; o < 32; o <<= 1) mx = fmaxf(mx, __shfl_xor(mx, o));
    if (F.lane == 0) red[F.wave] = mx;
    __syncthreads();
    if (F.tid == 0) { float m = red[0];
#pragma unroll
        for (int w = 1; w < 8; ++w) m = fmaxf(m, red[w]);
        atomicMax(kmax + ((int)blockIdx.x >> 4), __float_as_uint(m * 1.0001f)); }
    __syncthreads();
}

__device__ __forceinline__ void ret_state_unit(Frame& F, int unit, const bf16* rvT, const bf16* kwT, float* UT) {
    const int r = F.lane & 31, h2 = F.lane >> 5; const int h = unit & 3, bn = unit >> 2; const size_t m0 = (size_t)bn * 128;
    f32x16 acc[2][2];
#pragma unroll
    for (int i = 0; i < 2; ++i)
#pragma unroll
        for (int j = 0; j < 2; ++j) acc[i][j] = (f32x16){};
#pragma unroll
    for (int s = 0; s < 8; ++s) {
        bf16x8 af[2], bfr[2];
#pragma unroll
        for (int i = 0; i < 2; ++i) { af[i] = ld8(rvT + ((size_t)(unit * 2 + i) * 8 + s) * 512 + F.lane * 8); bfr[i] = ld8(kwT + ((size_t)(unit * 2 + i) * 8 + s) * 512 + F.lane * 8); }
#pragma unroll
        for (int et = 0; et < 2; ++et)
#pragma unroll
            for (int dt = 0; dt < 2; ++dt) acc[et][dt] = MFMA32(af[et], bfr[dt], acc[et][dt]);
    }
    float* dst = UT + (size_t)unit * 4096;
#pragma unroll
    for (int et = 0; et < 2; ++et)
#pragma unroll
        for (int dt = 0; dt < 2; ++dt)
#pragma unroll
            for (int reg = 0; reg < 16; ++reg) dst[(32 * et + crow(reg, h2)) * 64 + 32 * dt + r] = acc[et][dt][reg];
}

__device__ __forceinline__ void lru_carry_scan_wave(Frame& F, int seq, const float* carA, const float* carH, float* carIn) {
    const int b = seq >> 8, ch = seq & 255; const size_t base = ((size_t)b * 512 + 8 * F.lane) * 256 + ch;
    float a[8], hh[8];
#pragma unroll
    for (int j = 0; j < 8; ++j) { a[j] = carA[base + (size_t)j * 256]; hh[j] = carH[base + (size_t)j * 256]; }
    float Al = a[0], Hl = hh[0];
#pragma unroll
    for (int j = 1; j < 8; ++j) { Hl = a[j] * Hl + hh[j]; Al *= a[j]; }
#pragma unroll
    for (int d = 1; d < 64; d <<= 1) { const float Ap = __shfl_up(Al, d), Hp = __shfl_up(Hl, d); if (F.lane >= d) { Hl = Al * Hp + Hl; Al = Al * Ap; } }
    float c = __shfl_up(Hl, 1); if (F.lane == 0) c = 0.f;
#pragma unroll
    for (int j = 0; j < 8; ++j) { carIn[base + (size_t)j * 256] = c; c = a[j] * c + hh[j]; }
}
__device__ __forceinline__ void lru_carry_scan_wg(Frame& F, int g, const float* carA, const float* carH, float* carIn) {
    LAS float* sA = (LAS float*)(F.lds + RING_OFF); LAS float* sH = sA + 16 * 512;
    const int b = g >> 4, c0 = (g & 15) * 16, t = F.tid;
    const size_t rowo = ((size_t)b * 512 + t) * 256 + c0;
    f32x4 va[4], vh[4];
#pragma unroll
    for (int q = 0; q < 4; ++q) { va[q] = *(const f32x4*)(carA + rowo + 4 * q); vh[q] = *(const f32x4*)(carH + rowo + 4 * q); }
#pragma unroll
    for (int q = 0; q < 4; ++q)
#pragma unroll
        for (int e = 0; e < 4; ++e) { const int c = 4 * q + e, idx = c * 512 + (t ^ ((c & 7) << 2)); sA[idx] = va[q][e]; sH[idx] = vh[q][e]; }
    __syncthreads();
#pragma unroll
    for (int s_ = 0; s_ < 2; ++s_) {
        const int c = 2 * F.wave + s_, k = (c & 7) << 2; LAS float* pa = sA + c * 512, * ph = sH + c * 512;
        const f32x4 a0 = *(const LAS f32x4*)(pa + ((8 * F.lane) ^ k)), a1 = *(const LAS f32x4*)(pa + ((8 * F.lane + 4) ^ k));
        const f32x4 h0 = *(const LAS f32x4*)(ph + ((8 * F.lane) ^ k)), h1 = *(const LAS f32x4*)(ph + ((8 * F.lane + 4) ^ k));
        const float a[8] = {a0[0], a0[1], a0[2], a0[3], a1[0], a1[1], a1[2], a1[3]}, hh[8] = {h0[0], h0[1], h0[2], h0[3], h1[0], h1[1], h1[2], h1[3]};
        float Al = a[0], Hl = hh[0];
#pragma unroll
        for (int j = 1; j < 8; ++j) { Hl = a[j] * Hl + hh[j]; Al *= a[j]; }
#pragma unroll
        for (int d = 1; d < 64; d <<= 1) { const float Ap = __shfl_up(Al, d), Hp = __shfl_up(Hl, d); if (F.lane >= d) { Hl = Al * Hp + Hl; Al = Al * Ap; } }
        float cin = __shfl_up(Hl, 1); if (F.lane == 0) cin = 0.f;
        f32x4 o0, o1;
#pragma unroll
        for (int j = 0; j < 8; ++j) { if (j < 4) o0[j] = cin; else o1[j - 4] = cin; cin = a[j] * cin + hh[j]; }
        *(LAS f32x4*)(pa + ((8 * F.lane) ^ k)) = o0; *(LAS f32x4*)(pa + ((8 * F.lane + 4) ^ k)) = o1;
    }
    __syncthreads();
#pragma unroll
    for (int q = 0; q < 4; ++q) { f32x4 o;
#pragma unroll
        for (int e = 0; e < 4; ++e) { const int c = 4 * q + e; o[e] = sA[c * 512 + (t ^ ((c & 7) << 2))]; }
        *(f32x4*)(carIn + rowo + 4 * q) = o; }
    __syncthreads();
}
__device__ __forceinline__ void ret_state_scan_wg(Frame& F, const float* UT, bf16* PREV) {
    LAS float* E = (LAS float*)(F.lds + RING_OFF);
    const int sl = F.tid & 127, part = F.tid >> 7; const int gid = blockIdx.x * 128 + sl;
    if (blockIdx.x * 128 >= BATCH * 4 * 4096) return;
    const int b = gid >> 14, h = (gid >> 12) & 3, ed = gid & 4095;
    const float g1 = __builtin_amdgcn_exp2f(128.f * lg2gamma(h));
    float u[32];
#pragma unroll
    for (int k = 0; k < 32; ++k) u[k] = UT[((size_t)(b * 128 + 32 * part + k) * 4 + h) * 4096 + ed];
    float st = 0.f;
#pragma unroll
    for (int k = 0; k < 32; ++k) { const float t = u[k]; u[k] = st; st = g1 * st + t; }
    E[part * 128 + sl] = st;
    __syncthreads();
    float g32 = g1;
#pragma unroll
    for (int i = 0; i < 5; ++i) g32 *= g32;
    float c = 0.f;
    for (int pp = 0; pp < part; ++pp) c = g32 * c + E[pp * 128 + sl];
    float gk = 1.0f;
#pragma unroll
    for (int k = 0; k < 32; ++k) { PREV[((size_t)(b * 128 + 32 * part + k) * 4 + h) * 4096 + ed] = (bf16)(pk2(u[k] + gk * c, 0.f) & 0xffffu); gk *= g1; }
    __syncthreads();
}

__device__ __forceinline__ void fox_unit(Frame& F, int b, int h, int qt, const bf16* proj, const bf16* kfr, const bf16* fvT, const float* c2, bf16* mix, const unsigned* kmax) {
    const int r = F.lane & 31, h2 = F.lane >> 5;
    const size_t mb = (size_t)b * SEQ; const int q0 = 32 * qt;
    const float* cc = c2 + ((size_t)b * 8 + h) * SEQ;
    bf16x8 qf[4];
#pragma unroll
    for (int s = 0; s < 4; ++s) qf[s] = ld8(proj + (mb + q0 + r) * PKN + K_FQ + 64 * h + 16 * s + 8 * h2);
    const float cq = cc[q0 + r];
    float qn = 0.f;
#pragma unroll
    for (int s = 0; s < 4; ++s) { const v4u w = __builtin_bit_cast(v4u, qf[s]);
        qn += bflo(w.x) * bflo(w.x) + bfhi(w.x) * bfhi(w.x) + bflo(w.y) * bflo(w.y) + bfhi(w.y) * bfhi(w.y) + bflo(w.z) * bflo(w.z) + bfhi(w.z) * bfhi(w.z) + bflo(w.w) * bflo(w.w) + bfhi(w.w) * bfhi(w.w); }
    qn += __shfl_xor(qn, 32);
#pragma unroll
    for (int o_ = 1; o_ < 32; o_ <<= 1) qn = fmaxf(qn, __shfl_xor(qn, o_));
    const float smax = sqrtf(qn * 1.0001f) * sqrtf(__uint_as_float(kmax[b * 8 + h])) * 1.0001f;
    const float cq0 = cc[q0];
    float mrow = -1e30f, lsum = 0.f;
    f32x16 o[2]; o[0] = (f32x16){}; o[1] = (f32x16){};
    const bf16* kbase = kfr + ((size_t)(b * 8 + h) * 512 * 4) * 512 + F.lane * 8;
    const bf16* vbase = fvT + ((size_t)(b * 8 + h) * 512 * 4) * 512 + F.lane * 8;
    bf16x8 kA[4], vA[4], kB[4], vB[4]; f32x4 cA[4], cB[4];
#define FOX_LOAD(KF, VF, CK, t_) do { const int t__ = (t_) > 0 ? (t_) : 0; \
        _Pragma("unroll") for (int s = 0; s < 4; ++s) { KF[s] = ld8(kbase + (size_t)(t__ * 4 + s) * 512); VF[s] = ld8(vbase + (size_t)(t__ * 4 + s) * 512); } \
        _Pragma("unroll") for (int g = 0; g < 4; ++g) CK[g] = *(const f32x4*)(cc + 32 * t__ + 16 * (g >> 1) + 8 * h2 + 4 * (g & 1)); } while (0)
#define FOX_TILE(KF, VF, CK, DIAG) do { \
        f32x16 sc = (f32x16){}; \
        _Pragma("unroll") for (int s = 0; s < 4; ++s) sc = MFMA32(KF[s], qf[s], sc); \
        float mx = -1e30f; \
        _Pragma("unroll") for (int reg = 0; reg < 16; ++reg) { float x = sc[reg] + (cq - CK[reg >> 2][reg & 3]); \
            if (DIAG) { const int key = 16 * (reg >> 3) + 8 * h2 + (reg & 7); if (key > r) x = -1e30f; } \
            sc[reg] = x; mx = fmaxf(mx, x); } \
        mx = fmaxf(mx, __shfl_xor(mx, 32)); \
        const float mnew = fmaxf(mrow, mx); \
        if (__any(mnew > mrow)) { const float al = __builtin_amdgcn_exp2f(mrow - mnew); lsum *= al; \
            _Pragma("unroll") for (int reg = 0; reg < 16; ++reg) { o[0][reg] *= al; o[1][reg] *= al; } \
            mrow = mnew; } \
        float ps = 0.f; \
        _Pragma("unroll") for (int reg = 0; reg < 16; ++reg) { const float p = __builtin_amdgcn_exp2f(sc[reg] - mrow); sc[reg] = p; ps += p; } \
        lsum += ps; \
        const bf16x8 p0 = pack8(sc, 0), p1 = pack8(sc, 1); \
        o[0] = MFMA32(VF[0], p0, o[0]); o[0] = MFMA32(VF[1], p1, o[0]); \
        o[1] = MFMA32(VF[2], p0, o[1]); o[1] = MFMA32(VF[3], p1, o[1]); } while (0)
    FOX_LOAD(kA, vA, cA, qt); FOX_LOAD(kB, vB, cB, qt - 1);
    FOX_TILE(kA, vA, cA, true);
    int rem = 0;
    { float mm = mrow;
#pragma unroll
      for (int o_ = 1; o_ < 32; o_ <<= 1) mm = fminf(mm, __shfl_xor(mm, o_));
      const float thr = mm - FOX_T2;
      for (int base = qt - 1; base >= 0; base -= 64) { const int t = base - F.lane; bool alive = false;
          if (t >= 0) alive = !(smax + cq0 - cc[32 * t + 31] < thr);
          const int n = __popcll(__ballot(alive)); rem += n; if (n < 64) break; } }
    int kt = qt - 1;
    if (smax <= 48.0f) {
        f32x16 cinit;
#pragma unroll
        for (int reg = 0; reg < 16; ++reg) cinit[reg] = cq - mrow;
#define FOX_TILE_FAST(KF, VF, CK) do { \
        f32x16 sc = cinit; \
        _Pragma("unroll") for (int s = 0; s < 4; ++s) sc = MFMA32(KF[s], qf[s], sc); \
        float ps = 0.f; \
        _Pragma("unroll") for (int reg = 0; reg < 16; ++reg) { const float p_ = __builtin_amdgcn_exp2f(sc[reg] - CK[reg >> 2][reg & 3]); sc[reg] = p_; ps += p_; } \
        lsum += ps; \
        const bf16x8 p0 = pack8(sc, 0), p1 = pack8(sc, 1); \
        o[0] = MFMA32(VF[0], p0, o[0]); o[0] = MFMA32(VF[1], p1, o[0]); \
        o[1] = MFMA32(VF[2], p0, o[1]); o[1] = MFMA32(VF[3], p1, o[1]); } while (0)
        while (rem > 0) {
            FOX_LOAD(kA, vA, cA, kt - 1); FOX_TILE_FAST(kB, vB, cB); --kt; if (--rem == 0) break;
            FOX_LOAD(kB, vB, cB, kt - 1); FOX_TILE_FAST(kA, vA, cA); --kt; --rem;
        }
#undef FOX_TILE_FAST
    } else {
        while (rem > 0) {
            FOX_LOAD(kA, vA, cA, kt - 1); FOX_TILE(kB, vB, cB, false); --kt; if (--rem == 0) break;
            FOX_LOAD(kB, vB, cB, kt - 1); FOX_TILE(kA, vA, cA, false); --kt; --rem;
        }
    }
#undef FOX_LOAD
#undef FOX_TILE
    lsum += __shfl_xor(lsum, 32);
    const float inv = 1.0f / lsum;
    bf16* op = mix + (mb + q0 + r) * D + 256 + 64 * h;
#pragma unroll
    for (int et = 0; et < 2; ++et)
#pragma unroll
        for (int g = 0; g < 4; ++g) { v2u w; w.x = pk2(o[et][4 * g] * inv, o[et][4 * g + 1] * inv); w.y = pk2(o[et][4 * g + 2] * inv, o[et][4 * g + 3] * inv);
            *(v2u*)(op + 32 * et + 8 * g + 4 * h2) = w; }
}

__device__ __forceinline__ float gelu_tanh(float x) { const float u = 0.7978845608028654f * (x + 0.044715f * x * x * x); const float t = 1.0f - 2.0f * __builtin_amdgcn_rcpf(1.0f + __builtin_amdgcn_exp2f(2.0f * LOG2E * u)); return 0.5f * x * (1.0f + t); }
__device__ __forceinline__ void lru_final(Frame& F, const bf16* AC, const bf16* HL, const float* carIn, const bf16* proj, bf16* mix) {
    for (int it = blockIdx.x * (NWAVES * 64) + F.tid; it < M * 32; it += F.G * NWAVES * 64) {
        const int m = it >> 5, ch = (it & 31) * 8;
        const v4u wa = *(const v4u*)(AC + (size_t)m * 256 + ch), wh = *(const v4u*)(HL + (size_t)m * 256 + ch), wy = *(const v4u*)(proj + (size_t)m * PKN + K_LY + ch);
        const float* cp = carIn + (size_t)(m >> 5) * 256 + ch; const f32x4 c0 = *(const f32x4*)cp, c1 = *(const f32x4*)(cp + 4);
        float o[8];
        o[0] = (bflo(wh.x) + bflo(wa.x) * c0[0]) * gelu_tanh(bflo(wy.x)); o[1] = (bfhi(wh.x) + bfhi(wa.x) * c0[1]) * gelu_tanh(bfhi(wy.x));
        o[2] = (bflo(wh.y) + bflo(wa.y) * c0[2]) * gelu_tanh(bflo(wy.y)); o[3] = (bfhi(wh.y) + bfhi(wa.y) * c0[3]) * gelu_tanh(bfhi(wy.y));
        o[4] = (bflo(wh.z) + bflo(wa.z) * c1[0]) * gelu_tanh(bflo(wy.z)); o[5] = (bfhi(wh.z) + bfhi(wa.z) * c1[1]) * gelu_tanh(bfhi(wy.z));
        o[6] = (bflo(wh.w) + bflo(wa.w) * c1[2]) * gelu_tanh(bflo(wy.w)); o[7] = (bfhi(wh.w) + bfhi(wa.w) * c1[3]) * gelu_tanh(bfhi(wy.w));
        v4u w; w.x = pk2(o[0], o[1]); w.y = pk2(o[2], o[3]); w.z = pk2(o[4], o[5]); w.w = pk2(o[6], o[7]);
        *(v4u*)(mix + (size_t)m * D + ch) = w;
    }
}
__device__ __forceinline__ void ret_final_unit(Frame& F, int unit, const bf16* proj, const bf16* rkf, const bf16* rvT, const bf16* PREV, bf16* mix) {
    const int r = F.lane & 31, h2 = F.lane >> 5; const int h = unit & 3, bq = unit >> 2, qt = bq & 511, b = bq >> 9;
    const int n = qt >> 2, qi = qt & 3; const size_t mb = (size_t)b * SEQ, mc = mb + 128 * n, mq = mb + 32 * qt + r;
    const float lg = lg2gamma(h);
    bf16x8 qf[4];
#pragma unroll
    for (int s = 0; s < 4; ++s) qf[s] = ld8(proj + mq * PKN + K_RQ + 64 * h + 16 * s + 8 * h2);
    f32x16 y[2]; y[0] = (f32x16){}; y[1] = (f32x16){};
    for (int kt = 0; kt <= qi; ++kt) {
        const size_t kb = mc + 32 * kt;
        f32x16 sc = (f32x16){};
#pragma unroll
        for (int s = 0; s < 4; ++s) { const bf16x8 kf = ld8(rkf + ((size_t)((b * 4 + h) * 512 + 4 * n + kt) * 4 + s) * 512 + F.lane * 8); sc = MFMA32(kf, qf[s], sc); }
#pragma unroll
        for (int reg = 0; reg < 16; ++reg) { const int j = 32 * kt + 16 * (reg >> 3) + 8 * h2 + (reg & 7), i = 32 * qi + r, df = i - j;
            sc[reg] = df >= 0 ? sc[reg] * __builtin_amdgcn_exp2f((float)df * lg) : 0.f; }
        const bf16x8 p0 = pack8(sc, 0), p1 = pack8(sc, 1);
#pragma unroll
        for (int et = 0; et < 2; ++et) { const bf16* vp = rvT + ((size_t)(((b * 128 + n) * 4 + h) * 2 + et) * 8 + 2 * kt) * 512 + F.lane * 8; y[et] = MFMA32(ld8(vp), p0, y[et]); y[et] = MFMA32(ld8(vp + 512), p1, y[et]); }
    }
    const bf16* st = PREV + ((size_t)(b * 128 + n) * 4 + h) * 4096;
    const float qw = __builtin_amdgcn_exp2f((float)(32 * qi + r + 1) * lg);
    float s1 = 0.f;
#pragma unroll
    for (int et = 0; et < 2; ++et) { f32x16 yc = (f32x16){};
#pragma unroll
        for (int s = 0; s < 4; ++s) yc = MFMA32(ld8(st + (32 * et + r) * 64 + 16 * s + 8 * h2), qf[s], yc);
#pragma unroll
        for (int reg = 0; reg < 16; ++reg) { y[et][reg] += qw * yc[reg]; s1 += y[et][reg]; } }
    s1 += __shfl_xor(s1, 32);
    const float mu = s1 * (1.0f / 64.0f); float s2 = 0.f;
#pragma unroll
    for (int et = 0; et < 2; ++et)
#pragma unroll
        for (int reg = 0; reg < 16; ++reg) { const float d = y[et][reg] - mu; s2 += d * d; }
    s2 += __shfl_xor(s2, 32);
    const float rs = 1.0f / sqrtf(s2 * (1.0f / 64.0f) + EPS);
    const bf16* gp = proj + mq * PKN + K_RG + 64 * h; bf16* op = mix + mq * D + 768 + 64 * h;
#pragma unroll
    for (int et = 0; et < 2; ++et)
#pragma unroll
        for (int g = 0; g < 4; ++g) { const int e = 32 * et + 8 * g + 4 * h2; const v2u gw = *(const v2u*)(gp + e);
            const float g0 = bflo(gw.x), g1 = bfhi(gw.x), g2 = bflo(gw.y), g3 = bfhi(gw.y);
            v2u w; w.x = pk2(g0 * sigmoidf_(g0) * (y[et][4 * g] - mu) * rs, g1 * sigmoidf_(g1) * (y[et][4 * g + 1] - mu) * rs);
            w.y = pk2(g2 * sigmoidf_(g2) * (y[et][4 * g + 2] - mu) * rs, g3 * sigmoidf_(g3) * (y[et][4 * g + 3] - mu) * rs);
            *(v2u*)(op + e) = w; }
}


typedef const __attribute__((address_space(4))) Args* kargs_t;
#define KARGS() ({ kargs_t _p = (kargs_t)__builtin_amdgcn_kernarg_segment_ptr(); asm volatile("" : "+s"(_p)); _p; })
#define IN_F(i) ((const float*)ap->in[i])
#define x_in IN_F(0)
#define mem IN_F(1)
#define positions ((const int*)ap->in[2])
#define pre_mix_g IN_F(3)
#define post_mix_g IN_F(4)
#define w_in IN_F(5)
#define conv_w IN_F(6)
#define conv_b IN_F(7)
#define w_rg IN_F(8)
#define b_rg IN_F(9)
#define w_ig IN_F(10)
#define b_ig IN_F(11)
#define lru_lambda IN_F(12)
#define fox_b_f IN_F(13)
#define w_out IN_F(14)
#define pre_cross_g IN_F(15)
#define post_cross_g IN_F(16)
#define mem_norm_g IN_F(17)
#define w_cq IN_F(18)
#define w_ck IN_F(19)
#define w_cv IN_F(20)
#define w_co IN_F(21)
#define pre_ffn_g IN_F(22)
#define post_ffn_g IN_F(23)
#define w_gate IN_F(24)
#define w_up IN_F(25)
#define w_down IN_F(26)
#define xres (ap->out)
#define WSP(off) (ap->ws + (off))
#define WGT ((bf16*)WSP(WS_WGT))
#define LRUSP ((float*)WSP(WS_LRUSP))
#define MEMN ((bf16*)WSP(WS_MEMN))
#define LFT ((float*)WSP(WS_LFT))
#define C2 ((float*)WSP(WS_C2))
#define CARA ((float*)WSP(WS_CARA))
#define CARH ((float*)WSP(WS_CARH))
#define CARIN ((float*)WSP(WS_CARIN))
#define KMEM ((bf16*)WSP(WS_KMEM))
#define VTMEM ((bf16*)WSP(WS_VTMEM))
#define WCK ((bf16*)WSP(WS_WCK))
#define WCV ((bf16*)WSP(WS_WCV))
#define XB ((bf16*)WSP(WS_H))
#define RSTD ((float*)WSP(WS_RSTD))
#define MIX ((bf16*)WSP(WS_PT))
#define PK ((bf16*)WSP(WS_BIG))
#define PT ((bf16*)WSP(WS_PT))
#define PBUF ((bf16*)WSP(WS_BIG))
#define WQK ((bf16*)WSP(WS_KWT))
#define VWB ((bf16*)WSP(WS_KWT + 8 * MiB))
#define WCQS ((bf16*)WSP(WS_WCS))
#define WCOS ((bf16*)WSP(WS_WCS + 4 * MiB))
#define HFF ((bf16*)WSP(WS_BIG))
#define ACB ((bf16*)WSP(WS_AU))
#define HLB ((bf16*)WSP(WS_AU + 16 * MiB))
#define RAW ((bf16*)WSP(WS_AU - (3 * MiB + 12 * KiB + 768)))
#define KWT ((bf16*)WSP(WS_KWT))
#define RVT ((bf16*)WSP(WS_RVT))
#define RKF ((bf16*)WSP(WS_RKF))
#define FVT ((bf16*)WSP(WS_FVT))
#define FKF ((bf16*)WSP(WS_FKF))
#define UT ((float*)WSP(WS_UT))
#define PREV ((bf16*)WSP(WS_PREV))
#define WL(off) ((const bf16*)WSP(WS_W + (size_t)l * W_LAYER + (off)))
extern __shared__ __attribute__((aligned(16))) unsigned char g_lds[];
__device__ __forceinline__ void frame_init(Frame& F) {
    int t = threadIdx.x; asm volatile("" : "+v"(t));
    F.lds = (LAS unsigned char*)g_lds;
    F.MISC = (volatile LAS unsigned*)(F.lds + MISC_OFF);
    F.tid = t; F.lane = t & 63; F.wave = __builtin_amdgcn_readfirstlane(t >> 6);
    F.G = gridDim.x; F.gw = blockIdx.x * NWAVES + F.wave; F.NGW = F.G * NWAVES;
}
#ifndef PROBE_CAT
#define PROBE_CAT (-1)
#endif
#define PROBE_MULT 4u
#define PMISC ((volatile LAS unsigned*)((LAS unsigned char*)g_lds + MISC_OFF))
#define TS(cat) do { if (PROBE_CAT == (cat) && blockIdx.x == 0 && threadIdx.x == 0) PMISC[16] = (unsigned)__builtin_amdgcn_s_memrealtime(); } while (0)
#define TE(cat) do { if (PROBE_CAT == (cat) && blockIdx.x == 0 && threadIdx.x == 0) PMISC[17] += (unsigned)__builtin_amdgcn_s_memrealtime() - PMISC[16]; } while (0)
#define GRID_BAR() xcd_barrier(bar)
#define PH_BEGIN { kargs_t ap = KARGS(); Frame F; frame_init(F);
#define PH_END }
constexpr int CONV_PER_LAYER = 16 * 96 + 16 * 32 + 4 * (4 * 32) + 2 * 16 * 88 + 44 * 32 + 2 * 16 * 32;
constexpr int CONV_R_CO = 16 * 96 + 16 * 32, CONV_R_FFN = CONV_R_CO + 4 * (4 * 32), CONV_R_CK = CONV_R_FFN + 2 * 16 * 88 + 44 * 32;
constexpr int CONV_EARLY0 = CONV_R_FFN + (CONV_PER_LAYER - CONV_R_CK), CONV_EARLY1 = (CONV_R_FFN - CONV_R_CO) + (CONV_PER_LAYER - CONV_R_CK), CONV_EARLY = CONV_EARLY0 + CONV_EARLY1;
constexpr int CONV_LATE0 = CONV_R_CK - CONV_R_FFN, CONV_LATE1 = CONV_R_CO + (CONV_R_CK - CONV_R_FFN), CONV_LATE = CONV_LATE0 + CONV_LATE1;
static_assert(CONV_EARLY + CONV_LATE == 2 * CONV_PER_LAYER, "conversion item split");
__device__ __forceinline__ void conv_chain(Frame& F, kargs_t ap, LAS float* scr, const int l, const int r) {
    int o = 0;
    unsigned char* wl = WSP(WS_W + (size_t)l * W_LAYER);
    o = conv_matrix(F, scr, o, r, w_in + (size_t)l * D * INW, INW, D, 0, NPROJ, (bf16*)(wl + W_IN), 0, 1, pre_mix_g + l * D);
    o = conv_matrix(F, scr, o, r, w_out + (size_t)l * D * D, D, D, 0, D, (bf16*)(wl + W_OUT), 0, 0, nullptr);
    for (int hc = 0; hc < 4; ++hc)
        o = conv_matrix(F, scr, o, r, w_co + (size_t)l * D * D + (size_t)hc * 256 * D, D, 256, 0, D, WCOS + (size_t)(l * 4 + hc) * 1024 * 256, 0, 0, nullptr);
    o = conv_matrix(F, scr, o, r, w_gate + (size_t)l * D * DFF, DFF, D, 0, DFF, (bf16*)(wl + W_GU), 0, 2, pre_ffn_g + l * D);
    o = conv_matrix(F, scr, o, r, w_up + (size_t)l * D * DFF, DFF, D, 0, DFF, (bf16*)(wl + W_GU), 0, 3, pre_ffn_g + l * D);
    o = conv_matrix(F, scr, o, r, w_down + (size_t)l * DFF * D, D, DFF, 0, D, (bf16*)(wl + W_DN), 0, 0, nullptr);
    o = conv_matrix(F, scr, o, r, w_ck + (size_t)l * D * D, D, D, 0, D, WCK + (size_t)l * D * D, 0, 0, nullptr);
    o = conv_matrix(F, scr, o, r, w_cv + (size_t)l * D * D, D, D, 0, D, WCV + (size_t)l * D * D, 0, 0, nullptr);
}
template <int L> __device__ __forceinline__ void layer_fwd(const XcdBarrier& bar) {
    constexpr int l = L;
    TS(1); TS(8);
        PH_BEGIN
            pg8::Gemm g{XB, WL(W_IN), M, NPROJ, D, 9, 12}; pg8::StaticOrder S; S.init(M, NPROJ, F.G, (int)blockIdx.x);
            pg8::EpiProj E{PK, PKN, PT, PTN, C2FOX, RSTD, FVT, RVT, FKF};
            pg8::gemm_phase<pg8::EpiProj, pg8::StaticOrder, true, true>(F.lds + RING_OFF, g, S, E);
        PH_END
        GRID_BAR();
    TE(1); TE(8);
    TS(2); TS(16);
        PH_BEGIN
        { LAS float* tab = (LAS float*)(F.lds + LRU_TAB_OFF);
          for (int idx = F.tid; idx < 2048; idx += NWAVES * 64) { const int blk = idx >> 9, a = (idx >> 6) & 7, c = 64 * blk + (idx & 63);
              tab[idx] = a < 4 ? conv_w[(size_t)l * 4 * 256 + a * 256 + c] : a == 4 ? conv_b[l * 256 + c] : a == 5 ? b_rg[l * 256 + c] : a == 6 ? b_ig[l * 256 + c] : LRUSP[l * 256 + c]; }
          __syncthreads(); }
        for (int u = F.gw; u < 4096; u += F.NGW) lru_block_unit(F, u >> 2, u & 3, PT, WGT + (size_t)l * 2 * 4 * 64 * 64, ACB, HLB, CARA, CARH);
        PH_END
    if (PROBE_CAT == 16) __syncthreads();
    TE(16);
        PH_BEGIN
        if (F.gw < 1024) kchunk_unit(F, F.gw, PT, positions, RKF, RVT, UT);
        else {
            v4u wa[8], wb[8]; int v = F.gw - 1024;
            prep_load(F, v >> 2, v & 3, PK, PT, wa);
#pragma unroll 1
            while (v < 512 * 4) {
                const int vn = v + 1024;
                if (vn < 512 * 4) prep_load(F, vn >> 2, vn & 3, PK, PT, wb);
                prep_unit(F, v >> 2, v & 3, PK, PT, positions, RKF, KWT, RVT, FVT, wa);
#pragma unroll
                for (int i = 0; i < 8; ++i) wa[i] = wb[i];
                v = vn;
            }
        }
        PH_END
        GRID_BAR();
    TE(2);
    TS(3);
        if (L == 0) {
            PH_BEGIN
                const int c = (int)blockIdx.x - 128;
                if (c >= 0 && c < 16) { pg8::Gemm g{MEMN, WCK, BATCH * MEML, 2 * D, D}; pg8::StaticOrder S; S.init(BATCH * MEML, 2 * D, F.G, c);
                    pg8::EpiBlock E{KMEM, 256, 2};
                    pg8::gemm_phase<pg8::EpiBlock, pg8::StaticOrder, true, true>(F.lds + RING_OFF, g, S, E); }
            PH_END
            PH_BEGIN
                const int c = (int)blockIdx.x - 144;
                if (c >= 0 && c < 16) { pg8::Gemm g{MEMN, WCV, BATCH * MEML, 2 * D, D}; pg8::StaticOrder S; S.init(BATCH * MEML, 2 * D, F.G, c);
                    pg8::EpiBlock E{VTMEM, 256, 2};
                    pg8::gemm_phase<pg8::EpiBlock, pg8::StaticOrder, true, true>(F.lds + RING_OFF, g, S, E); }
            PH_END
        }
        PH_BEGIN
        v4u kn[16]; fox_knorm_load(F, FKF, kn);
        if (blockIdx.x < 32) lru_carry_scan_wg(F, (int)blockIdx.x, CARA, CARH, CARIN);
        ret_state_scan_wg(F, UT, PREV);
        __syncthreads(); fox_knorm_reduce(F, kn, (unsigned*)WSP(WS_CTL) + CW_FOXK + 16 * l);
        PH_END
        if (L == 0 && (blockIdx.x < 128 || (blockIdx.x >= 160 && blockIdx.x < 240))) {
            __syncthreads();
            PH_BEGIN
                LAS float* scr = (LAS float*)(F.lds + RING_OFF + F.wave * 16384);
                const int wl_ = ((int)blockIdx.x < 128 ? (int)blockIdx.x : (int)blockIdx.x - 32) * NWAVES + F.wave;
                for (int f = wl_; f < CONV_LATE; f += 208 * NWAVES) {
                    int l, r;
                    if (f < CONV_LATE0) { l = 0; r = CONV_R_FFN + f; }
                    else { const int f1 = f - CONV_LATE0; l = 1; r = f1 < CONV_R_CO ? f1 : CONV_R_FFN + (f1 - CONV_R_CO); }
                    conv_chain(F, ap, scr, l, r);
                }
            PH_END
        }
        if (blockIdx.x >= 240) { __syncthreads(); PH_BEGIN cscan_job(F, LFT, C2, (int)blockIdx.x - 240); PH_END }
        PH_BEGIN
        PH_END
        GRID_BAR();
    TE(3);
    TS(4);
        PH_BEGIN
        PH_END
        PH_BEGIN
            const int x = (int)blockIdx.x;
            if (F.G == 256) {
#pragma unroll 1
                for (int i = 0; i < 4; ++i) { const int bh = ((x & 15) + 5 * i) & 15, qb = (x >> 4) + 16 * i;
                    fox_unit(F, bh >> 3, bh & 7, 8 * qb + F.wave, PK, FKF, FVT, C2, MIX, (const unsigned*)WSP(WS_CTL) + CW_FOXK + 16 * l); }
            }
        PH_END
        PH_BEGIN
        lru_final(F, ACB, HLB, CARIN, PK, MIX);
#pragma unroll 1
        for (int i = 0; i < 2; ++i) { const int u0 = F.gw + i * F.NGW; if (u0 < 4096) { const int u = i == 0 ? u0 : ((((u0 >> 2)) ^ 3) << 2) | (u0 & 3); ret_final_unit(F, u, PK, RKF, RVT, PREV, MIX); } }
        PH_END
        GRID_BAR();
    TE(4);
    TS(1); TS(9);
        PH_BEGIN
            pg8::Gemm g{MIX, WL(W_OUT), M, D, D}; pg8::StaticOrder S; S.init(M, D, F.G, (int)blockIdx.x);
            pg8::EpiPlain E{RAW, D, 1.f, 0, 0, nullptr, nullptr, 0, 1 << 30};
            pg8::gemm_phase<pg8::EpiPlain, pg8::StaticOrder, true, true>(F.lds + RING_OFF, g, S, E);
        PH_END
        GRID_BAR();
    TE(1); TE(9);
    TS(7);
        if (L == 0) {
            PH_BEGIN
                pg8::Gemm g{KMEM, WCQS, 16 * 256, 8 * 1024, 256}; pg8::PairOrder S{(int)blockIdx.x, false};
                pg8::EpiBlock E{WQK, 1024, 0};
                pg8::gemm_phase<pg8::EpiBlock, pg8::PairOrder, true, true>(F.lds + RING_OFF, g, S, E);
            PH_END
            PH_BEGIN
                pg8::Gemm g{WCOS, VTMEM, 8 * 1024, 16 * 256, 256}; pg8::PairOrder S{(int)blockIdx.x - 64, true};
                pg8::EpiBlock E{VWB, 1024, 1};
                pg8::gemm_phase<pg8::EpiBlock, pg8::PairOrder, true, true>(F.lds + RING_OFF, g, S, E);
            PH_END
        }
        if (L == 0) {
            PH_BEGIN
            if (blockIdx.x < 128) thin4<1>(F, RAW, XB, XB, nullptr, post_mix_g + l * D, RSTD, 0, 12288, F.gw, 1024);
            else thin4<1>(F, RAW, XB, XB, nullptr, post_mix_g + l * D, RSTD, 12288, M, F.gw - 1024, 1024);
            PH_END
        } else {
            PH_BEGIN
            thin_pass<1, false>(F, RAW, nullptr, XB, nullptr, post_mix_g + l * D, RSTD, nullptr, nullptr, nullptr, nullptr);
            PH_END
        }
        GRID_BAR();
    TE(7);
    TS(1); TS(10);
        PH_BEGIN
            pg8::Gemm g{XB, WQK + (size_t)l * 2 * 1024 * 1024, M, D, D, 0, 0, (size_t)1024 * 1024 * 2, 6}; pg8::StaticOrder S; S.init(M, D, F.G, (int)blockIdx.x);
            pg8::EpiSoftmax E{PBUF, RSTD, (LAS float*)(F.lds + LRU_TAB_OFF)};
            pg8::gemm_phase<pg8::EpiSoftmax, pg8::StaticOrder, true, true>(F.lds + RING_OFF, g, S, E);
        PH_END
        GRID_BAR();
    TE(1); TE(10);
    TS(1); TS(11);
        PH_BEGIN
            pg8::Gemm g{PBUF, VWB + (size_t)l * 2 * 1024 * 1024, M, D, D, 0, 0, (size_t)1024 * 1024 * 2, 6}; pg8::StaticOrder S; S.init(M, D, F.G, (int)blockIdx.x);
            pg8::EpiPlain E{RAW, D, 1.f, 0, 0, nullptr, nullptr, 0, 1 << 30};
            pg8::gemm_phase<pg8::EpiPlain, pg8::StaticOrder, true, true>(F.lds + RING_OFF, g, S, E);
        PH_END
        GRID_BAR();
    TE(1); TE(11);
    TS(7);
        PH_BEGIN
        thin_pass<1, false>(F, RAW, nullptr, XB, nullptr, post_cross_g + l * D, RSTD, nullptr, nullptr, nullptr, nullptr);
        PH_END
        GRID_BAR();
    TE(7);
    TS(1); TS(12);
        PH_BEGIN
            pg8::Gemm g{XB, WL(W_GU), M, 2 * DFF, D}; pg8::StaticOrder S; S.init(M, 2 * DFF, F.G, (int)blockIdx.x);
            pg8::EpiSwiGLU E{HFF, DFF, RSTD};
            pg8::gemm_phase<pg8::EpiSwiGLU, pg8::StaticOrder, true, true>(F.lds + RING_OFF, g, S, E);
        PH_END
        GRID_BAR();
    TE(1); TE(12);
    TS(1); TS(13);
        PH_BEGIN
            pg8::Gemm g{HFF, WL(W_DN), M, D, DFF}; pg8::StaticOrder S; S.init(M, D, F.G, (int)blockIdx.x);
            pg8::EpiPlain E{RAW, D, 1.f, 0, 0, nullptr, nullptr, 0, 1 << 30};
            pg8::gemm_phase<pg8::EpiPlain, pg8::StaticOrder, true, true>(F.lds + RING_OFF, g, S, E);
        PH_END
        GRID_BAR();
    TE(1); TE(13);
    TS(7);
        if (l == 0) { PH_BEGIN thin_pass<1, true>(F, RAW, nullptr, XB, nullptr, post_ffn_g + l * D, RSTD, pre_mix_g + (l + 1) * D, w_in + (size_t)(l + 1) * D * INW, fox_b_f + (l + 1) * 8, LFT); PH_END GRID_BAR(); }
        else { PH_BEGIN thin_pass<2, false>(F, RAW, nullptr, XB, xres, post_ffn_g + l * D, nullptr, nullptr, nullptr, nullptr, nullptr); PH_END }
    TE(7);
}

__global__ void __launch_bounds__(NWAVES * 64, 2) hymba_fwd(Args args) {
    for (int u = threadIdx.x; u < (LDS_BYTES - LDSCTL_OFF) / 4; u += NWAVES * 64) ((LAS unsigned*)((LAS unsigned char*)g_lds + LDSCTL_OFF))[u] = 0u;
    __syncthreads();
    XcdBarrier bar = xcd_barrier_post((unsigned*)(args.ws + WS_CTL) + CW_BAR, (volatile LAS unsigned*)((LAS unsigned char*)g_lds + MISC_OFF) + 8);
    TS(0);
    PH_BEGIN
        LAS float* scr = (LAS float*)(F.lds + RING_OFF + F.wave * 16384);
        for (int e = F.gw; e < CONV_EARLY; e += F.NGW) {
            int l, r;
            if (e < CONV_EARLY0) { l = 0; r = e < CONV_R_FFN ? e : e - CONV_R_FFN + CONV_R_CK; }
            else { const int e1 = e - CONV_EARLY0; l = 1; r = e1 < CONV_R_FFN - CONV_R_CO ? CONV_R_CO + e1 : CONV_R_CK + (e1 - (CONV_R_FFN - CONV_R_CO)); }
            conv_chain(F, ap, scr, l, r);
        }
        for (int it = blockIdx.x * (NWAVES * 64) + F.tid; it < 2 * 4 * 1024 * 32; it += F.G * NWAVES * 64) {
            const int d8 = it & 31, hin = (it >> 5) & 1023, hc = (it >> 15) & 3, l = it >> 17;
            const float* src = w_cq + (size_t)l * D * D + (size_t)hin * D + 256 * hc + 8 * d8; const f32x4 a = *(const f32x4*)src, b = *(const f32x4*)(src + 4);
            const float g = pre_cross_g[l * D + hin] * C2CROSS;
            v4u o; o.x = pk2(a[0] * g, a[1] * g); o.y = pk2(a[2] * g, a[3] * g); o.z = pk2(b[0] * g, b[1] * g); o.w = pk2(b[2] * g, b[3] * g);
            *(v4u*)(WCQS + ((size_t)((l * 4 + hc) * 1024 + hin)) * 256 + 8 * d8) = o;
        }
        for (int e = blockIdx.x * (NWAVES * 64) + F.tid; e < 2 * 2 * 4 * 64 * 64; e += F.G * NWAVES * 64) {
            const int q = e & 7, ln = (e >> 3) & 63, s_ = (e >> 9) & 3, jt = (e >> 11) & 1, blk = (e >> 12) & 3, gate = (e >> 14) & 1, l = e >> 15;
            const int i = 16 * s_ + 8 * (ln >> 5) + q, j = 32 * jt + (ln & 31);
            const float* src = gate ? w_ig : w_rg; WGT[e] = (bf16)(pk2(src[(((size_t)l * 4 + blk) * 64 + i) * 64 + j], 0.f) & 0xffffu);
        }
        if (blockIdx.x == 0) { const int e = F.tid; const float lam = lru_lambda[e]; LRUSP[e] = 8.0f * log1pf(expf(-lam)); }
        for (int row = F.gw; row < BATCH * MEML; row += F.NGW) {
            f32x4 v[4]; float ss = 0.f;
#pragma unroll
            for (int j = 0; j < 4; ++j) { v[j] = *(const f32x4*)(mem + (size_t)row * D + 4 * F.lane + 256 * j); ss += (v[j][0] * v[j][0] + v[j][1] * v[j][1]) + (v[j][2] * v[j][2] + v[j][3] * v[j][3]); }
            const float rstd = 1.0f / sqrtf(wave_sum(ss) * (1.0f / D) + EPS);
#pragma unroll
            for (int j = 0; j < 4; ++j) { const f32x4 g = *(const f32x4*)(mem_norm_g + 4 * F.lane + 256 * j); v2u w; w.x = pk2(v[j][0] * rstd * g[0], v[j][1] * rstd * g[1]); w.y = pk2(v[j][2] * rstd * g[2], v[j][3] * rstd * g[3]);
                *(v2u*)(MEMN + (size_t)row * D + 4 * F.lane + 256 * j) = w; }
        }
        __syncthreads();
    PH_END
    PH_BEGIN
        thin_pass<0, true>(F, nullptr, x_in, XB, nullptr, nullptr, RSTD, pre_mix_g, w_in, fox_b_f, LFT);
    PH_END
    GRID_BAR();
    TE(0);
    layer_fwd<0>(bar);
    layer_fwd<1>(bar);
    if (PROBE_CAT >= 0 && blockIdx.x == 0 && threadIdx.x == 0) {
        const unsigned acc = PMISC[17]; const unsigned long long t0 = __builtin_amdgcn_s_memrealtime();
        while ((unsigned)(__builtin_amdgcn_s_memrealtime() - t0) < PROBE_MULT * acc) __builtin_amdgcn_s_sleep(20);
    }
}

extern "C" void kernel_launch(void* const* d_in, const int* in_sizes, int n_in, void* d_out, int out_size, void* d_ws, size_t ws_size, hipStream_t stream) {
    static int grid = 0;
    if (grid == 0) {
        if (n_in != 27 || in_sizes[0] != M * D || out_size != M * D || ws_size < WS_END) { fprintf(stderr, "kernel_launch: unexpected shapes / workspace (n_in %d, ws %zu, need %zu); nothing launched\n", n_in, ws_size, (size_t)WS_END); grid = -1; return; }
        int dev = 0, cus = 0;
        if (hipGetDevice(&dev) != hipSuccess || hipDeviceGetAttribute(&cus, hipDeviceAttributeMultiprocessorCount, dev) != hipSuccess) { grid = -1; return; }
        if (hipFuncSetAttribute((const void*)hymba_fwd, hipFuncAttributeMaxDynamicSharedMemorySize, LDS_BYTES) != hipSuccess) { fprintf(stderr, "kernel_launch: hipFuncSetAttribute failed\n"); grid = -1; return; }
        (void)hipGetLastError();
        if (cus < 256) { fprintf(stderr, "kernel_launch: needs 256 CUs\n"); grid = -1; return; }
        grid = 256;
    }
    if (grid < 0) return;
    if (hipMemsetAsync((char*)d_ws + WS_CTL, 0, CTL_ZERO_BYTES, stream) != hipSuccess) return;
    Args a{};
    for (int i = 0; i < 27; ++i) a.in[i] = (const float*)d_in[i];
    a.out = (float*)d_out; a.ws = (unsigned char*)d_ws;
    hipLaunchKernelGGL(hymba_fwd, dim3(grid), dim3(NWAVES * 64), LDS_BYTES, stream, a);
}
```

```cpp
#include <hip/hip_runtime.h>
#include <cstdio>
#include <cstdint>
namespace pg8 {
#define PG8_LAS __attribute__((address_space(3)))
typedef unsigned short bf16_t;
typedef short bf16x8 __attribute__((ext_vector_type(8)));
typedef float f32x4 __attribute__((ext_vector_type(4)));
typedef unsigned u32x4 __attribute__((ext_vector_type(4)));
constexpr int BM = 256, BK = 64, HALF = 128, HTB = HALF * BK * 2  , STAGE_BYTES = 8 * HTB, NXCD = 8, WGM = 8;

__host__ __device__ __forceinline__ int lds_byte(int r, int c) { const int st = (r >> 4) * 2 + (c >> 5), rr = r & 15, cc = c & 31, ob = rr * 64 + cc * 2; return st * 1024 + (ob ^ (((ob >> 9) & 1) << 5)); }
__host__ __device__ __forceinline__ void stage_rc(int b, int& R, int& C) { const int st = b / 1024, sb = b % 1024, swz = sb ^ (((sb >> 9) & 1) << 5); R = (st >> 1) * 16 + swz / 64; C = (st & 1) * 32 + (swz % 64) / 2; }
__host__ __device__ __forceinline__ int perm32(int rho) { const int n = rho >> 4, i = rho & 15; return 8 * (i >> 2) + 4 * n + (i & 3); }

struct Unit { int pm, pn; };
struct Gemm;
struct Gemm { const bf16_t* A; const bf16_t* Bt; int M, N, K; int sw_lo = 0, sw_hi = 0; size_t bb_stride = 0; int bb_shift = 30;     __host__ __device__ bool swapped(const Unit& u) const { return u.pn >= sw_lo && u.pn < sw_hi; } };

struct StaticOrder {
    int nM, nN, nwg, G, c;
    __host__ __device__ __forceinline__ void init(int M, int N, int G_, int c_) { nM = M / BM; nN = N / BM; nwg = nM * nN; G = G_; c = c_; }
    __host__ __device__ __forceinline__ bool next(int i, Unit& u) const {
        const long L = (long)i * G + c; if (L >= nwg) return false;
        int wgid = (int)L; { const int q = nwg / NXCD, r = nwg % NXCD, xcd = wgid % NXCD, off = wgid / NXCD; wgid = (xcd < r ? xcd * (q + 1) : r * (q + 1) + (xcd - r) * q) + off; }
        const int nig = WGM * nN, gid = wgid / nig, fm = gid * WGM, gsz = (nM - fm) < WGM ? (nM - fm) : WGM;
        u.pm = fm + ((wgid % nig) % gsz); u.pn = (wgid % nig) / gsz; return true;
    }
    __device__ __forceinline__ void a_ready(const Unit&) const {}
    __device__ __forceinline__ void done(const Unit&) const {}
};


typedef float f32x2 __attribute__((ext_vector_type(2)));
typedef __bf16 bf16x2_t __attribute__((ext_vector_type(2)));
__device__ __forceinline__ unsigned cvt_pk_bf16(float lo, float hi) { f32x2 v = {lo, hi}; bf16x2_t b = __builtin_convertvector(v, bf16x2_t); return __builtin_bit_cast(unsigned, b); }
typedef unsigned u32x2s __attribute__((ext_vector_type(2)));
__device__ __forceinline__ float max_x16_x32(float v) {
    u32x2s r = __builtin_amdgcn_permlane16_swap(__float_as_uint(v), __float_as_uint(v), false, false); v = fmaxf(__uint_as_float(r.x), __uint_as_float(r.y));
    r = __builtin_amdgcn_permlane32_swap(__float_as_uint(v), __float_as_uint(v), false, false); return fmaxf(__uint_as_float(r.x), __uint_as_float(r.y)); }
__device__ __forceinline__ float sum_x16_x32(float v) {
    u32x2s r = __builtin_amdgcn_permlane16_swap(__float_as_uint(v), __float_as_uint(v), false, false); v = __uint_as_float(r.x) + __uint_as_float(r.y);
    r = __builtin_amdgcn_permlane32_swap(__float_as_uint(v), __float_as_uint(v), false, false); return __uint_as_float(r.x) + __uint_as_float(r.y); }

struct EpiPlain {
    static constexpr bool PERM = true, AFTER_DRAIN = false;
    bf16_t* O; int ldc; float sc; int sc_lo, sc_hi; const float* rs; bf16_t* O1; int ldc1, nsplit;
    __device__ __forceinline__ void operator()(const f32x4 (&acc)[2][2][4][2], const Unit& u, int wr, int wc, int fr, int fq) const {
        const int row0 = u.pm * BM + wr * 64 + fr;
        bf16_t* base = O; int ld = ldc, pn = u.pn; if (pn >= nsplit) { base = O1; ld = ldc1; pn -= nsplit; }
        const int col0 = pn * BM + wc * 32 + 8 * fq;
        const float s = (u.pn >= sc_lo && u.pn < sc_hi) ? sc : 1.f;
#pragma unroll
        for (int ai = 0; ai < 2; ++ai)
#pragma unroll
            for (int m = 0; m < 4; ++m) { const int row = row0 + ai * HALF + m * 16; bf16_t* rowp = base + (size_t)row * ld + col0;
                const float sr = rs ? rs[row] * s : s;
#pragma unroll
                for (int bj = 0; bj < 2; ++bj) { const f32x4 v0 = acc[ai][bj][m][0] * sr, v1 = acc[ai][bj][m][1] * sr;
                    u32x4 w; w.x = cvt_pk_bf16(v0[0], v0[1]); w.y = cvt_pk_bf16(v0[2], v0[3]); w.z = cvt_pk_bf16(v1[0], v1[1]); w.w = cvt_pk_bf16(v1[2], v1[3]);
                    *(u32x4*)(rowp + bj * HALF) = w; } }
    }
};
struct EpiProj {
    static constexpr bool PERM = true, AFTER_DRAIN = false;
    bf16_t* PKp; int ldk; bf16_t* PTp; int ldt; float sc; const float* rs; bf16_t* vf; bf16_t* rvf; bf16_t* kf;
    __device__ __forceinline__ void operator()(const f32x4 (&acc)[2][2][4][2], const Unit& u, int wr, int wc, int fr, int fq) const {
        if (u.pn < 7) {
            const int row0 = u.pm * BM + wr * 64 + fr;
            bf16_t* base = PKp; int ld = ldk, pn = u.pn; if (pn >= 5) { base = PTp; ld = ldt; pn -= 5; }
            const int col0 = pn * BM + wc * 32 + 8 * fq;
            const float s = (u.pn == 1 || u.pn == 2) ? sc : 1.f;
#pragma unroll
            for (int ai = 0; ai < 2; ++ai)
#pragma unroll
                for (int m = 0; m < 4; ++m) { const int row = row0 + ai * HALF + m * 16; bf16_t* rowp = base + (size_t)row * ld + col0;
                    const float sr = rs[row] * s;
#pragma unroll
                    for (int bj = 0; bj < 2; ++bj) { const f32x4 v0 = acc[ai][bj][m][0] * sr, v1 = acc[ai][bj][m][1] * sr;
                        u32x4 w; w.x = cvt_pk_bf16(v0[0], v0[1]); w.y = cvt_pk_bf16(v0[2], v0[3]); w.z = cvt_pk_bf16(v1[0], v1[1]); w.w = cvt_pk_bf16(v1[2], v1[3]);
                        *(u32x4*)(rowp + bj * HALF) = w; } }
        } else if (u.pn < 9) {
            const int b = u.pm >> 6;
#pragma unroll
            for (int ai = 0; ai < 2; ++ai)
#pragma unroll
                for (int m = 0; m < 4; ++m) { const int rt = ai * HALF + wr * 64 + m * 16 + fr; const int tb = (u.pm & 63) * BM + rt;
                    const float sr = rs[u.pm * BM + rt];
                    const int rl = tb & 31, rsw = (rl & 0x13) | ((rl & 4) << 1) | ((rl & 8) >> 1);
#pragma unroll
                    for (int bj = 0; bj < 2; ++bj) { const int c = 256 * (u.pn - 7) + bj * HALF + wc * 32 + 8 * fq; const int h = c >> 6, ch = (c & 63) >> 3;
                        bf16_t* dst = kf + ((size_t)((((b * 8 + h) * 512 + (tb >> 5)) * 4 + (ch >> 1)) * 64) + rsw + 32 * (ch & 1)) * 8;
                        const f32x4 v0 = acc[ai][bj][m][0] * sr, v1 = acc[ai][bj][m][1] * sr;
                        u32x4 w; w.x = cvt_pk_bf16(v0[0], v0[1]); w.y = cvt_pk_bf16(v0[2], v0[3]); w.z = cvt_pk_bf16(v1[0], v1[1]); w.w = cvt_pk_bf16(v1[2], v1[3]);
                        *(u32x4*)dst = w; } }
        } else {
            const int b = u.pm >> 6;
#pragma unroll
            for (int bj = 0; bj < 2; ++bj) {
                const int c0 = bj * HALF + wc * 32 + 8 * fq; const int tb = (u.pm & 63) * BM + c0;
                const f32x4 r0 = *(const f32x4*)(rs + u.pm * BM + c0), r1 = *(const f32x4*)(rs + u.pm * BM + c0 + 4);
                const int h2 = (tb >> 3) & 1;
#pragma unroll
                for (int ai = 0; ai < 2; ++ai)
#pragma unroll
                    for (int m = 0; m < 4; ++m) { const int f = ai * HALF + wr * 64 + m * 16 + fr;
                        const int e = f & 63, et = e >> 5, re = e & 31; bf16_t* dst;
                        if (u.pn < 11) { const int h = (256 * (u.pn - 9) + f) >> 6; dst = vf + ((size_t)((((b * 8 + h) * 512 + (tb >> 5)) * 4 + 2 * et + ((tb >> 4) & 1)) * 64) + re + 32 * h2) * 8; }
                        else { const int h = f >> 6; dst = rvf + ((size_t)(((((b * 128 + (tb >> 7)) * 4 + h) * 2 + et) * 8 + ((tb >> 4) & 7)) * 64) + re + 32 * h2) * 8; }
                        const f32x4 v0 = acc[ai][bj][m][0] * r0, v1 = acc[ai][bj][m][1] * r1;
                        u32x4 w; w.x = cvt_pk_bf16(v0[0], v0[1]); w.y = cvt_pk_bf16(v0[2], v0[3]); w.z = cvt_pk_bf16(v1[0], v1[1]); w.w = cvt_pk_bf16(v1[2], v1[3]);
                        *(u32x4*)dst = w; }
            }
        }
    }
};
struct EpiBlock {
    static constexpr bool PERM = true, AFTER_DRAIN = false;
    bf16_t* O; int ldc, mode;
    __device__ __forceinline__ void operator()(const f32x4 (&acc)[2][2][4][2], const Unit& u, int wr, int wc, int fr, int fq) const {
        int rb, cb;
        if (mode == 2) { rb = (((u.pn >> 2) * 2 + u.pm) * 4 + (u.pn & 3)) * 256; cb = 0; }
        else if (mode == 0) { rb = (u.pm >> 2) * 1024 + (u.pm & 3) * 256; cb = (u.pn & 3) * 256; }
        else { rb = (u.pn >> 2) * 1024 + (u.pm & 3) * 256; cb = (u.pn & 3) * 256; }
        const int row0 = rb + wr * 64 + fr, col0 = cb + wc * 32 + 8 * fq;
#pragma unroll
        for (int ai = 0; ai < 2; ++ai)
#pragma unroll
            for (int m = 0; m < 4; ++m) { bf16_t* rowp = O + (size_t)(row0 + ai * HALF + m * 16) * ldc + col0;
#pragma unroll
                for (int bj = 0; bj < 2; ++bj) { const f32x4 v0 = acc[ai][bj][m][0], v1 = acc[ai][bj][m][1];
                    u32x4 w; w.x = cvt_pk_bf16(v0[0], v0[1]); w.y = cvt_pk_bf16(v0[2], v0[3]); w.z = cvt_pk_bf16(v1[0], v1[1]); w.w = cvt_pk_bf16(v1[2], v1[3]);
                    *(u32x4*)(rowp + bj * HALF) = w; } }
    }
};
struct PairOrder {
    int c; bool vw;
    __host__ __device__ __forceinline__ bool next(int i, Unit& u) const {
        if (i != 0 || c < 0 || c >= 64) return false;
        const int nt = c & 3, q = c >> 2, hc = q & 3, lb = q >> 2, l = lb >> 1;
        if (!vw) { u.pm = q; u.pn = (l * 4 + hc) * 4 + nt; } else { u.pm = (l * 4 + hc) * 4 + nt; u.pn = q; }
        return true;
    }
    __device__ __forceinline__ void a_ready(const Unit&) const {}
    __device__ __forceinline__ void done(const Unit&) const {}
};
struct EpiSoftmax {
    static constexpr bool PERM = true, AFTER_DRAIN = false;
    bf16_t* O; const float* rs; PG8_LAS float* ex;
    __device__ __forceinline__ void operator()(f32x4 (&acc)[2][2][4][2], const Unit& u, int wr, int wc, int fr, int fq) const {
        typedef float f32x2v __attribute__((ext_vector_type(2)));
        PG8_LAS f32x2v* EX = (PG8_LAS f32x2v*)ex;
#pragma unroll
        for (int ai = 0; ai < 2; ++ai)
#pragma unroll
            for (int m = 0; m < 4; ++m) { const int rl = ai * HALF + wr * 64 + m * 16 + fr; const float sr = rs[u.pm * BM + rl];
                float mx = -3.0e38f;
#pragma unroll
                for (int bj = 0; bj < 2; ++bj)
#pragma unroll
                    for (int n = 0; n < 2; ++n) { f32x4 x = acc[ai][bj][m][n] * sr; acc[ai][bj][m][n] = x; mx = fmaxf(fmaxf(mx, fmaxf(x[0], x[1])), fmaxf(x[2], x[3])); }
                mx = max_x16_x32(mx);
                float sm = 0.f;
#pragma unroll
                for (int bj = 0; bj < 2; ++bj)
#pragma unroll
                    for (int n = 0; n < 2; ++n) { f32x4 x = acc[ai][bj][m][n];
                        x[0] = __builtin_amdgcn_exp2f(x[0] - mx); x[1] = __builtin_amdgcn_exp2f(x[1] - mx); x[2] = __builtin_amdgcn_exp2f(x[2] - mx); x[3] = __builtin_amdgcn_exp2f(x[3] - mx);
                        acc[ai][bj][m][n] = x; sm += (x[0] + x[1]) + (x[2] + x[3]); }
                sm = sum_x16_x32(sm);
                if (fq == 0) EX[rl * 4 + wc] = (f32x2v){mx, sm}; }
        asm volatile("s_waitcnt lgkmcnt(0)" ::: "memory"); __builtin_amdgcn_s_barrier(); asm volatile("" ::: "memory");
        const int row0 = u.pm * BM + wr * 64 + fr, col0 = u.pn * BM + wc * 32 + 8 * fq;
#pragma unroll
        for (int ai = 0; ai < 2; ++ai)
#pragma unroll
            for (int m = 0; m < 4; ++m) { const int rl = ai * HALF + wr * 64 + m * 16 + fr;
                const f32x2v e0 = EX[rl * 4 + 0], e1 = EX[rl * 4 + 1], e2 = EX[rl * 4 + 2], e3 = EX[rl * 4 + 3];
                const float ma = fmaxf(fmaxf(e0.x, e1.x), fmaxf(e2.x, e3.x));
                const float sa = (e0.y * __builtin_amdgcn_exp2f(e0.x - ma) + e1.y * __builtin_amdgcn_exp2f(e1.x - ma)) + (e2.y * __builtin_amdgcn_exp2f(e2.x - ma) + e3.y * __builtin_amdgcn_exp2f(e3.x - ma));
                const float mine = wc == 0 ? e0.x : wc == 1 ? e1.x : wc == 2 ? e2.x : e3.x;
                const float f = __builtin_amdgcn_exp2f(mine - ma) * __builtin_amdgcn_rcpf(sa);
                bf16_t* rowp = O + (size_t)(row0 + ai * HALF + m * 16) * 1024 + col0;
#pragma unroll
                for (int bj = 0; bj < 2; ++bj) { const f32x4 v0 = acc[ai][bj][m][0] * f, v1 = acc[ai][bj][m][1] * f;
                    u32x4 w; w.x = cvt_pk_bf16(v0[0], v0[1]); w.y = cvt_pk_bf16(v0[2], v0[3]); w.z = cvt_pk_bf16(v1[0], v1[1]); w.w = cvt_pk_bf16(v1[2], v1[3]);
                    *(u32x4*)(rowp + bj * HALF) = w; } }
    }
};
struct EpiSwiGLU {
    static constexpr bool PERM = true, AFTER_DRAIN = false;
    bf16_t* O; int ldc; const float* rs;
    __device__ __forceinline__ void operator()(const f32x4 (&acc)[2][2][4][2], const Unit& u, int wr, int wc, int fr, int fq) const {
        const int row0 = u.pm * BM + wr * 64 + fr; const int col0 = u.pn * HALF + wc * 32 + 8 * fq;
#pragma unroll
        for (int ai = 0; ai < 2; ++ai)
#pragma unroll
            for (int m = 0; m < 4; ++m) { const int row = row0 + ai * HALF + m * 16; bf16_t* rowp = O + (size_t)row * ldc + col0;
                const float sr = rs[row];
                float o[8];
#pragma unroll
                for (int n = 0; n < 2; ++n)
#pragma unroll
                    for (int i = 0; i < 4; ++i) { const float g = acc[ai][0][m][n][i] * sr, up = acc[ai][1][m][n][i] * sr;
                        const float sg = g * __builtin_amdgcn_rcpf(1.0f + __builtin_amdgcn_exp2f(-1.4426950408889634f * g)); o[4 * n + i] = sg * up; }
                u32x4 w; w.x = cvt_pk_bf16(o[0], o[1]); w.y = cvt_pk_bf16(o[2], o[3]); w.z = cvt_pk_bf16(o[4], o[5]); w.w = cvt_pk_bf16(o[6], o[7]);
                *(u32x4*)rowp = w; }
    }
};

template <class Epi, class Sched, bool ALIGN_EPI = false, bool SP2 = false>
__device__ __forceinline__ void gemm_phase(PG8_LAS unsigned char* lds, const Gemm g, const Sched& S, const Epi& E) {
    int tid_ = threadIdx.x; asm volatile("" : "+v"(tid_));
    const int tid = tid_, wid = __builtin_amdgcn_readfirstlane(tid >> 6), lane = tid & 63, wr = wid >> 2, wc = wid & 3, fr = lane & 15, fq = lane >> 4;
    const int K = g.K, nt = K / BK;
    unsigned voffA[2], voffB[2];
#pragma unroll
    for (int i = 0; i < 2; ++i) { int R, C; stage_rc(tid * 16 + i * 8192, R, C); const int Rb = Epi::PERM ? ((R & ~31) + perm32(R & 31)) : R;
        voffA[i] = (unsigned)(R * K + C) * 2u; voffB[i] = (unsigned)(Rb * K + C) * 2u; }
    const size_t kstep = (size_t)(BK * 2);
    const size_t hstep = (size_t)HALF * K * 2;
    const size_t tstep = 2 * hstep;
    const unsigned ldsw = (unsigned)wid * 1024u;
    const int aoff = lds_byte(wr * 64 + fr, fq * 8), boff = lds_byte(wc * 32 + fr, fq * 8);
#define PG8_SA(b, h) (((b) * 2 + (h)) * HTB)
#define PG8_SB(b, h) ((4 + (b) * 2 + (h)) * HTB)
#define PG8_STAGE(bufoff, gbase, voff) do { _Pragma("unroll") for (int _i = 0; _i < 2; ++_i) \
        __builtin_amdgcn_global_load_lds((const unsigned*)((const char*)(gbase) + (voff)[_i]), (PG8_LAS unsigned*)(lds + (bufoff) + ldsw + _i * 8192), 16, 0, 0); } while (0)
#define PG8_LDA(dst, b, h) do { _Pragma("unroll") for (int m = 0; m < 4; ++m) _Pragma("unroll") for (int k = 0; k < 2; ++k) dst[m][k] = *(const PG8_LAS bf16x8*)(lds + PG8_SA(b, h) + aoff + m * 2048 + k * 1024); } while (0)
#define PG8_LDB(dst, b, h) do { _Pragma("unroll") for (int n = 0; n < 2; ++n) _Pragma("unroll") for (int k = 0; k < 2; ++k) dst[n][k] = *(const PG8_LAS bf16x8*)(lds + PG8_SB(b, h) + boff + n * 2048 + k * 1024); } while (0)
#define PG8_MMA(ai, bj, At, Bt) do { __builtin_amdgcn_s_setprio(1); _Pragma("unroll") for (int m = 0; m < 4; ++m) _Pragma("unroll") for (int n = 0; n < 2; ++n) _Pragma("unroll") for (int k = 0; k < 2; ++k) \
        acc[ai][bj][m][n] = __builtin_amdgcn_mfma_f32_16x16x32_bf16(Bt[n][k], At[m][k], acc[ai][bj][m][n], 0, 0, 0); __builtin_amdgcn_s_setprio(0); } while (0)
#define PG8_WAIT_V(n) asm volatile("s_waitcnt vmcnt(" #n ")" ::: "memory")
#define PG8_WAIT_L(n) asm volatile("s_waitcnt lgkmcnt(" #n ")" ::: "memory")
#define PG8_BAR __builtin_amdgcn_s_barrier()
#define PG8_SCHED __builtin_amdgcn_sched_barrier(0)
    Unit cur, nxt; int ui = 0;
    if (!S.next(0, cur)) return;
    f32x4 acc[2][2][4][2];
#pragma unroll
    for (int a = 0; a < 2; ++a)
#pragma unroll
        for (int b = 0; b < 2; ++b)
#pragma unroll
            for (int m = 0; m < 4; ++m)
#pragma unroll
                for (int n = 0; n < 2; ++n) acc[a][b][m][n] = (f32x4){0.f, 0.f, 0.f, 0.f};
    bf16x8 At[4][2], B0[2][2], B1[2][2];
    const char* cA = (const char*)g.A + (size_t)cur.pm * tstep; const char* cB = (const char*)g.Bt + (size_t)cur.pn * tstep + (size_t)(cur.pm >> g.bb_shift) * g.bb_stride;
    if (g.swapped(cur)) { const char* t_ = cA; cA = cB; cB = t_; }
    S.a_ready(cur);
    if constexpr (SP2) {
        PG8_STAGE(PG8_SB(0, 0), cB, voffB); PG8_STAGE(PG8_SB(0, 1), cB + hstep, voffB); PG8_STAGE(PG8_SA(0, 0), cA, voffA); PG8_STAGE(PG8_SA(0, 1), cA + hstep, voffA);
        if (wr == 1) PG8_BAR;
        PG8_WAIT_V(2); PG8_BAR;
        PG8_STAGE(PG8_SB(1, 0), cB + kstep, voffB); PG8_STAGE(PG8_SA(1, 0), cA + kstep, voffA); PG8_STAGE(PG8_SB(1, 1), cB + hstep + kstep, voffB);
        PG8_WAIT_V(6); PG8_BAR;
    } else {
        PG8_STAGE(PG8_SB(0, 0), cB, voffB); PG8_STAGE(PG8_SA(0, 0), cA, voffA); PG8_STAGE(PG8_SB(0, 1), cB + hstep, voffB); PG8_STAGE(PG8_SA(0, 1), cA + hstep, voffA);
        if (wr == 1) PG8_BAR;
        PG8_WAIT_V(4); PG8_BAR;
        PG8_STAGE(PG8_SB(1, 0), cB + kstep, voffB); PG8_STAGE(PG8_SA(1, 0), cA + kstep, voffA); PG8_STAGE(PG8_SB(1, 1), cB + hstep + kstep, voffB);
        PG8_WAIT_V(6); PG8_BAR;
    }
    for (;;) {
        const bool has_next = S.next(ui + 1, nxt);
        const char* nA = has_next ? (const char*)g.A + (size_t)nxt.pm * tstep : cA; const char* nB = has_next ? (const char*)g.Bt + (size_t)nxt.pn * tstep + (size_t)(nxt.pm >> g.bb_shift) * g.bb_stride : cB;
        if (has_next && g.swapped(nxt)) { const char* t_ = nA; nA = nB; nB = t_; }
        for (int t = 0; t < nt; t += 2) {
            const bool last = (t == nt - 2);
            const char* a1 = cA + (size_t)(t + 1) * kstep;
            const char* a2 = last ? nA : cA + (size_t)(t + 2) * kstep; const char* b2 = last ? nB : cB + (size_t)(t + 2) * kstep;
            const char* a3 = a2 + kstep; const char* b3 = b2 + kstep;
            if (last && has_next) S.a_ready(nxt);
            if constexpr (SP2) {
            PG8_LDB(B0, 0, 0); PG8_LDB(B1, 0, 1); PG8_SCHED; PG8_LDA(At, 0, 0); PG8_STAGE(PG8_SA(1, 1), a1 + hstep, voffA);
            PG8_WAIT_V(8); PG8_WAIT_L(0); PG8_BAR; PG8_MMA(0, 0, At, B0); PG8_MMA(0, 1, At, B1); PG8_BAR; PG8_SCHED;
            PG8_LDA(At, 0, 1); PG8_STAGE(PG8_SB(0, 0), b2, voffB); PG8_STAGE(PG8_SB(0, 1), b2 + hstep, voffB); PG8_STAGE(PG8_SA(0, 0), a2, voffA);
            PG8_WAIT_V(8); PG8_WAIT_L(0); PG8_BAR; PG8_MMA(1, 0, At, B0); PG8_MMA(1, 1, At, B1); PG8_BAR; PG8_SCHED;
            PG8_LDB(B0, 1, 0); PG8_LDB(B1, 1, 1); PG8_SCHED; PG8_LDA(At, 1, 0); PG8_STAGE(PG8_SA(0, 1), a2 + hstep, voffA);
            PG8_WAIT_V(8); PG8_WAIT_L(0); PG8_BAR; PG8_MMA(0, 0, At, B0); PG8_MMA(0, 1, At, B1); PG8_BAR; PG8_SCHED;
            PG8_LDA(At, 1, 1); PG8_STAGE(PG8_SB(1, 0), b3, voffB); PG8_STAGE(PG8_SB(1, 1), b3 + hstep, voffB); PG8_STAGE(PG8_SA(1, 0), a3, voffA);
            PG8_WAIT_V(8); PG8_WAIT_L(0); PG8_BAR; PG8_MMA(1, 0, At, B0); PG8_MMA(1, 1, At, B1); PG8_BAR; PG8_SCHED;
            } else {
            PG8_LDB(B0, 0, 0); PG8_SCHED; PG8_LDA(At, 0, 0); PG8_STAGE(PG8_SA(1, 1), a1 + hstep, voffA);
            PG8_WAIT_L(8); PG8_BAR; PG8_WAIT_L(0); PG8_MMA(0, 0, At, B0); PG8_BAR; PG8_SCHED;
            PG8_LDB(B1, 0, 1); PG8_STAGE(PG8_SB(0, 0), b2, voffB);
            PG8_BAR; PG8_WAIT_L(0); PG8_MMA(0, 1, At, B1); PG8_BAR;
            PG8_LDA(At, 0, 1); PG8_STAGE(PG8_SA(0, 0), a2, voffA);
            PG8_BAR; PG8_WAIT_L(0); PG8_MMA(1, 0, At, B0); PG8_BAR; PG8_SCHED;
            PG8_STAGE(PG8_SB(0, 1), b2 + hstep, voffB);
            PG8_WAIT_V(6); PG8_BAR; PG8_MMA(1, 1, At, B1); PG8_BAR;
            PG8_LDB(B0, 1, 0); PG8_SCHED; PG8_LDA(At, 1, 0); PG8_STAGE(PG8_SA(0, 1), a2 + hstep, voffA);
            PG8_WAIT_L(8); PG8_BAR; PG8_WAIT_L(0); PG8_MMA(0, 0, At, B0); PG8_BAR; PG8_SCHED;
            PG8_LDB(B1, 1, 1); PG8_STAGE(PG8_SB(1, 0), b3, voffB);
            PG8_BAR; PG8_WAIT_L(0); PG8_MMA(0, 1, At, B1); PG8_BAR;
            PG8_LDA(At, 1, 1); PG8_STAGE(PG8_SA(1, 0), a3, voffA);
            PG8_BAR; PG8_WAIT_L(0); PG8_MMA(1, 0, At, B0); PG8_BAR; PG8_SCHED;
            PG8_STAGE(PG8_SB(1, 1), b3 + hstep, voffB);
            PG8_WAIT_V(6); PG8_BAR; PG8_MMA(1, 1, At, B1); PG8_BAR;
            }
        }
        if constexpr (ALIGN_EPI) { if (wr == 0) PG8_BAR; }
        if constexpr (!Epi::AFTER_DRAIN) { E(acc, cur, wr, wc, fr, fq); S.done(cur); }
        if (!has_next) break;
#pragma unroll
        for (int a = 0; a < 2; ++a)
#pragma unroll
            for (int b = 0; b < 2; ++b)
#pragma unroll
                for (int m = 0; m < 4; ++m)
#pragma unroll
                    for (int n = 0; n < 2; ++n) acc[a][b][m][n] = (f32x4){0.f, 0.f, 0.f, 0.f};
        cur = nxt; cA = nA; cB = nB; ++ui;
        if constexpr (ALIGN_EPI) { if (wr == 1) PG8_BAR; }
    }
    PG8_WAIT_V(0);
    if constexpr (!ALIGN_EPI) { if (wr == 0) PG8_BAR; }
    PG8_BAR;
    if constexpr (Epi::AFTER_DRAIN) { E.fused(acc, cur, wr, wc, fr, fq, lds, wid, lane); S.done(cur); }
#undef PG8_SA
#undef PG8_SB
#undef PG8_STAGE
#undef PG8_LDA
#undef PG8_LDB
#undef PG8_MMA
#undef PG8_WAIT_V
#undef PG8_WAIT_L
#undef PG8_BAR
#undef PG8_SCHED
}
}

constexpr int NWAVES = 8;
constexpr int BATCH = 2, SEQ = 16384, M = BATCH * SEQ, D = 1024, NPROJ = 3072, INW = 3080, DFF = 2816, MEML = 256;
constexpr int PKN = 1280, PTN = 512;
constexpr int K_LY = 0, K_FQ = 256, K_RQ = 768, K_RG = 1024, T_LX = 0, T_RK = 256;
constexpr float EPS = 1e-6f;
constexpr float LOG2E = 1.4426950408889634f;
constexpr float C2FOX = 0.125f * 1.4426950408889634f;
constexpr float C2CROSS = 0.0625f * 1.4426950408889634f;
#ifndef FOX_PRUNE
#define FOX_PRUNE 0
#endif

constexpr size_t MiB = 1u << 20, KiB = 1u << 10;
constexpr size_t WS_CTL = 0, CTL_ZERO_BYTES = 1 * MiB;
constexpr size_t WS_WGT = 1 * MiB;
constexpr size_t WS_LRUSP = WS_WGT + 128 * KiB;
constexpr size_t WS_RSTD = WS_WGT + 256 * KiB;
constexpr size_t WS_FOXMAX = WS_LRUSP + 4 * KiB;
constexpr size_t WS_MEMN = 2 * MiB;
constexpr size_t WS_LFT = 3 * MiB;
constexpr size_t WS_C2 = 4 * MiB;
constexpr size_t WS_CARA = 5 * MiB, WS_CARH = 6 * MiB, WS_CARIN = 11 * MiB;
constexpr size_t WS_KMEM = 7 * MiB;
constexpr size_t WS_VTMEM = 9 * MiB;
constexpr size_t WS_W = 12 * MiB;
constexpr size_t W_IN = 0, W_OUT = W_IN + (size_t)NPROJ * D * 2, W_CQ = W_OUT + (size_t)D * D * 2, W_CO = W_CQ + (size_t)D * D * 2,
                 W_GU = W_CO + (size_t)D * D * 2, W_DN = W_GU + (size_t)2 * DFF * D * 2, W_LAYER = W_DN + (size_t)D * DFF * 2;
constexpr size_t WS_WCK = WS_W + 2 * W_LAYER, WS_WCV = WS_WCK + (size_t)2 * D * D * 2, WS_WEND = WS_WCV + (size_t)2 * D * D * 2;
constexpr size_t WS_H = 77 * MiB;
constexpr size_t WS_BIG = 141 * MiB;
constexpr size_t WS_PT = WS_BIG + (size_t)M * PKN * 2;
constexpr size_t WS_AU = 333 * MiB;
constexpr size_t WS_KWT = 397 * MiB, WS_RVT = 413 * MiB, WS_FVT = 429 * MiB;
constexpr size_t WS_FKF = WS_AU + 32 * MiB;
constexpr size_t WS_UT = 461 * MiB, WS_PREV = 477 * MiB, WS_RKF = 485 * MiB, WS_WCS = 501 * MiB, WS_END = 509 * MiB;
static_assert(WS_WEND <= WS_H && WS_H + (size_t)M * D * 2 <= WS_BIG && WS_BIG + (size_t)M * NPROJ * 2 <= WS_AU && WS_AU + (size_t)M * 256 * 8 <= WS_KWT, "ws map");
constexpr int CW_BAR = 4096;
constexpr int CW_FOXK = 8192;
constexpr float FOX_T2 = 45.0f;

constexpr int RING_OFF = 0, RING_BYTES = 131072;
constexpr int LDSCTL_OFF = RING_BYTES, MISC_OFF = LDSCTL_OFF + 320;
constexpr int LDS_BYTES = 147456;
constexpr int LRU_TAB_OFF = 131072 + 512;

#define GAS __attribute__((address_space(1)))
#define LAS __attribute__((address_space(3)))
typedef unsigned short bf16;
typedef unsigned v4u __attribute__((ext_vector_type(4)));
typedef unsigned v2u __attribute__((ext_vector_type(2)));
typedef float f32x4 __attribute__((ext_vector_type(4)));
typedef float f32x16 __attribute__((ext_vector_type(16)));
typedef short bf16x8 __attribute__((ext_vector_type(8)));
typedef GAS unsigned gu32;
#define RLX_AGENT __ATOMIC_RELAXED, __HIP_MEMORY_SCOPE_AGENT
#define LDS_WAIT() asm volatile("s_waitcnt lgkmcnt(0)" ::: "memory")
#define VM_WAIT() asm volatile("s_waitcnt vmcnt(0)" ::: "memory")
#define MFMA32(a, b, c) __builtin_amdgcn_mfma_f32_32x32x16_bf16((a), (b), (c), 0, 0, 0)
__device__ __forceinline__ unsigned pk2(float lo, float hi) { return pg8::cvt_pk_bf16(lo, hi); }
__device__ __forceinline__ float bflo(unsigned w) { return __uint_as_float(w << 16); }
__device__ __forceinline__ float bfhi(unsigned w) { return __uint_as_float(w & 0xffff0000u); }
__device__ __forceinline__ int crow(int r, int hi) { return (r & 3) + 8 * (r >> 2) + 4 * hi; }
__device__ __forceinline__ int swap23(int r) { return (r & 0x13) | ((r & 4) << 1) | ((r & 8) >> 1); }
__device__ __forceinline__ bf16x8 ld8(const bf16* p) { return *(const bf16x8*)p; }
__device__ __forceinline__ bf16x8 pack8(const f32x16& x, int s) {
    v4u p; p.x = pk2(x[8 * s], x[8 * s + 1]); p.y = pk2(x[8 * s + 2], x[8 * s + 3]); p.z = pk2(x[8 * s + 4], x[8 * s + 5]); p.w = pk2(x[8 * s + 6], x[8 * s + 7]);
    return __builtin_bit_cast(bf16x8, p); }
__device__ __forceinline__ float sum_x32(float v) { const v2u r = __builtin_amdgcn_permlane32_swap(__float_as_uint(v), __float_as_uint(v), false, false); return __uint_as_float(r.x) + __uint_as_float(r.y); }
__device__ __forceinline__ float max_x32(float v) { const v2u r = __builtin_amdgcn_permlane32_swap(__float_as_uint(v), __float_as_uint(v), false, false); return fmaxf(__uint_as_float(r.x), __uint_as_float(r.y)); }
template <int CTRL> __device__ __forceinline__ float dpp_mov(float v) { return __int_as_float(__builtin_amdgcn_update_dpp(0, __float_as_int(v), CTRL, 0xf, 0xf, true)); }
__device__ __forceinline__ float sum_x16(float v) { const v2u r = __builtin_amdgcn_permlane16_swap(__float_as_uint(v), __float_as_uint(v), false, false); return __uint_as_float(r.x) + __uint_as_float(r.y); }
__device__ __forceinline__ float max_x16(float v) { const v2u r = __builtin_amdgcn_permlane16_swap(__float_as_uint(v), __float_as_uint(v), false, false); return fmaxf(__uint_as_float(r.x), __uint_as_float(r.y)); }
__device__ __forceinline__ float min_x16(float v) { const v2u r = __builtin_amdgcn_permlane16_swap(__float_as_uint(v), __float_as_uint(v), false, false); return fminf(__uint_as_float(r.x), __uint_as_float(r.y)); }
__device__ __forceinline__ float wave_sum(float v) {
    v += dpp_mov<0xB1>(v); v += dpp_mov<0x4E>(v); v += dpp_mov<0x141>(v); v += dpp_mov<0x140>(v);
    return sum_x32(sum_x16(v));
}
__device__ __forceinline__ float max_over32(float v) {
    v = fmaxf(v, dpp_mov<0xB1>(v)); v = fmaxf(v, dpp_mov<0x4E>(v)); v = fmaxf(v, dpp_mov<0x141>(v)); v = fmaxf(v, dpp_mov<0x140>(v)); return max_x16(v); }
__device__ __forceinline__ float min_over32(float v) {
    v = fminf(v, dpp_mov<0xB1>(v)); v = fminf(v, dpp_mov<0x4E>(v)); v = fminf(v, dpp_mov<0x141>(v)); v = fminf(v, dpp_mov<0x140>(v)); return min_x16(v); }
__device__ __forceinline__ float sigmoidf_(float x) { return __builtin_amdgcn_rcpf(1.0f + __builtin_amdgcn_exp2f(-LOG2E * x)); }
__device__ __forceinline__ float lg2gamma(int h) { return h == 0 ? -0.04580368961312479f : h == 1 ? -0.02272007650008353f : h == 2 ? -0.011315313227834146f : -0.005646563141142063f; }

#define XB_TMO      128
#define XB_XCNT(j)  (256  + 64 * (j))
#define XB_XSUB(j)  (1280 + 64 * (j))
#define XB_XGEN(j)  (2304 + 64 * (j))
#define XB_TOP      3328
#define XB_TOPGEN   3392
#define XCD_BAR_WORDS 3456
#define XB_SPIN_CAP (1u << 18)

__device__ __forceinline__ unsigned xb_ld(unsigned* p)              { return __hip_atomic_load(p, __ATOMIC_RELAXED, __HIP_MEMORY_SCOPE_AGENT); }
__device__ __forceinline__ unsigned xb_add(unsigned* p, unsigned v) { return __hip_atomic_fetch_add(p, v, __ATOMIC_RELAXED, __HIP_MEMORY_SCOPE_AGENT); }
__device__ __forceinline__ unsigned xb_xcc_id() { return (unsigned)__builtin_amdgcn_s_getreg((3 << 11) | 20) & 0xFu; }
#define XB_SPIN(cond, bar) do { unsigned _sp = 0; while (cond) { __builtin_amdgcn_s_sleep(1); \
    if ((++_sp & 255u) == 0u) { if (xb_ld(&(bar)[XB_TMO])) break; if (_sp > XB_SPIN_CAP) { atomicAdd(&(bar)[XB_TMO], 1u); break; } } } } while (0)

struct XcdBarrier {
    unsigned* bar; unsigned x;
    volatile LAS unsigned* st;
};

__device__ __forceinline__ XcdBarrier xcd_barrier_post(unsigned* bar, volatile LAS unsigned* st) {
    XcdBarrier b; b.bar = bar; b.x = xb_xcc_id(); b.st = st;
    if (threadIdx.x == 0) (void)xb_add(&bar[XB_XCNT(b.x)], 1u);
    return b;
}
__device__ __forceinline__ void xcd_barrier_complete(unsigned* bar, unsigned x, unsigned& nloc, unsigned& nx) {
    const unsigned G = gridDim.x * gridDim.y * gridDim.z;
    unsigned sum, cnt, mine, sp = 0u;
    for (;;) {
        sum = 0u; cnt = 0u; mine = 0u;
#pragma unroll
        for (unsigned j = 0; j < 16; ++j) { const unsigned c = xb_ld(&bar[XB_XCNT(j)]); sum += c; cnt += (c > 0u) ? 1u : 0u; mine = (j == x) ? c : mine; }
        if (sum == G) break;
        __builtin_amdgcn_s_sleep(1);
        if ((++sp & 255u) == 0u) { if (xb_ld(&bar[XB_TMO])) break; if (sp > XB_SPIN_CAP) { atomicAdd(&bar[XB_TMO], 1u); break; } }
    }
    nloc = mine > 0u ? mine : 1u; nx = cnt > 0u ? cnt : 1u;
}

__device__ __forceinline__ void xcd_barrier(const XcdBarrier& b) {
    asm volatile("s_waitcnt vmcnt(0)" ::: "memory");
    __syncthreads();
    if (threadIdx.x == 0) {
        unsigned* bar = b.bar;
        __builtin_amdgcn_s_waitcnt(0);
        unsigned nloc = b.st[0], nx = b.st[1];
        if (nloc == 0u) { xcd_barrier_complete(bar, b.x, nloc, nx); b.st[0] = nloc; b.st[1] = nx; }
        const unsigned old = xb_add(&bar[XB_XSUB(b.x)], 1u);
        const unsigned gen = old / nloc;
        if (old + 1u == (gen + 1u) * nloc) {
            __builtin_amdgcn_fence(__ATOMIC_RELEASE, "agent");
            asm volatile("s_waitcnt vmcnt(0)" ::: "memory");
            const unsigned og = xb_add(&bar[XB_TOP], 1u);
            const unsigned tg = og / nx;
            if (og + 1u == (tg + 1u) * nx) xb_add(&bar[XB_TOPGEN], 1u);
            else XB_SPIN(xb_ld(&bar[XB_TOPGEN]) == tg, bar);
            __builtin_amdgcn_fence(__ATOMIC_ACQUIRE, "agent");
            xb_add(&bar[XB_XGEN(b.x)], 1u);
            asm volatile("s_waitcnt vmcnt(0)" ::: "memory");
        } else {
            XB_SPIN(xb_ld(&bar[XB_XGEN(b.x)]) == gen, bar);
            __builtin_amdgcn_fence(__ATOMIC_ACQUIRE, "agent");
            asm volatile("s_waitcnt vmcnt(0)" ::: "memory");
        }
    }
    __syncthreads();
}

struct Args { const float* in[27]; float* out; unsigned char* ws; };
struct Frame {
    LAS unsigned char* lds;
    volatile LAS unsigned* MISC;
    gu32* ctl;
    int tid, lane, wave;
    int G, gw, NGW;
    unsigned char* ws;
};

__device__ __forceinline__ void transpose_item(const float* W, int ldw, int k0, int n0, bf16* WT, int K, int dn0, LAS float* scr, int lane, const float* gain) {
    float wv[32];
#pragma unroll
    for (int i = 0; i < 32; ++i) wv[i] = W[(size_t)(k0 + 2 * i + (lane >> 5)) * ldw + n0 + (lane & 31)];
#pragma unroll
    for (int i = 0; i < 32; ++i) { const int kk = 2 * i + (lane >> 5); const float g = gain ? gain[k0 + kk] : 1.0f; scr[kk * 33 + (lane & 31)] = g * wv[i]; }
    LDS_WAIT(); asm volatile("" ::: "memory");
    const int c = lane & 7;
#pragma unroll
    for (int j = 0; j < 4; ++j) { const int n = (lane >> 3) + 8 * j; const LAS float* s = scr + (8 * c) * 33 + n;
        v4u o; o.x = pk2(s[0 * 33], s[1 * 33]); o.y = pk2(s[2 * 33], s[3 * 33]); o.z = pk2(s[4 * 33], s[5 * 33]); o.w = pk2(s[6 * 33], s[7 * 33]);
        *(GAS v4u*)(WT + (size_t)(dn0 + n) * K + k0 + 8 * c) = o; }
    LDS_WAIT(); asm volatile("" ::: "memory");
}
__device__ __forceinline__ int conv_matrix(Frame& F, LAS float* scr, int it0, int it, const float* W, int ldw, int K, int csrc0, int ncols, bf16* WT, int drow0, int mode, const float* gain) {
    const int nblk = ncols / 32, nitems = (K / 64) * nblk;
    const int r = it - it0;
    if (r >= 0 && r < nitems) {
        const int kb = r / nblk, nb = r % nblk; int n0 = csrc0 + 32 * nb, dn0;
        if (mode == 0) dn0 = drow0 + 32 * nb;
        else if (mode == 1) { dn0 = 32 * nb; const int t = dn0 >> 8;
            const int st = t == 0 ? 256 : t == 1 ? 512 : t == 2 ? 768 : t == 3 ? 2056 : t == 4 ? 2824 : t == 5 ? 0 : t == 6 ? 2312 : t == 7 ? 1024 : t == 8 ? 1280 : t == 9 ? 1536 : t == 10 ? 1792 : 2568;
            n0 = st + (dn0 & 255); }
        else { const int j = 32 * nb; dn0 = 256 * (j / 128) + 128 * (mode - 2) + (j % 128); }
        transpose_item(W, ldw, 64 * kb, n0, WT, K, dn0, scr, F.lane, gain);
    }
    return it0 + nitems;
}

template <int MODE, bool HAS_FF>
__device__ __forceinline__ void thin_pass(Frame& F, const bf16* raw, const float* xin, bf16* xb, float* out, const float* gpost, float* rstd, const float* gpre,
                                          const float* win_l  , const float* bfox, float* lfT) {
    LAS float* wfT = (LAS float*)(F.lds + RING_OFF);
    if (HAS_FF) {
        for (int k = F.tid; k < D; k += NWAVES * 64) { const f32x4 a = *(const f32x4*)(win_l + (size_t)k * INW + 2048), b = *(const f32x4*)(win_l + (size_t)k * INW + 2052);
            wfT[0 * D + k] = a[0]; wfT[1 * D + k] = a[1]; wfT[2 * D + k] = a[2]; wfT[3 * D + k] = a[3]; wfT[4 * D + k] = b[0]; wfT[5 * D + k] = b[1]; wfT[6 * D + k] = b[2]; wfT[7 * D + k] = b[3]; }
        __syncthreads();
    }
    f32x4 gp[4], gq[4];
#pragma unroll
    for (int j = 0; j < 4; ++j) { gp[j] = MODE >= 1 ? *(const f32x4*)(gpost + 4 * F.lane + 256 * j) : (f32x4){0.f, 0.f, 0.f, 0.f}; gq[j] = HAS_FF ? *(const f32x4*)(gpre + 4 * F.lane + 256 * j) : (f32x4){0.f, 0.f, 0.f, 0.f}; }
    for (int row = F.gw; row < M; row += F.NGW) {
        f32x4 x[4];
        if (MODE == 0) {
#pragma unroll
            for (int j = 0; j < 4; ++j) x[j] = *(const f32x4*)(xin + (size_t)row * D + 4 * F.lane + 256 * j);
        } else {
            f32x4 rw[4]; float ss = 0.f;
#pragma unroll
            for (int j = 0; j < 4; ++j) { const v2u w = *(const v2u*)(raw + (size_t)row * D + 4 * F.lane + 256 * j), wx = *(const v2u*)(xb + (size_t)row * D + 4 * F.lane + 256 * j);
                rw[j] = (f32x4){bflo(w.x), bfhi(w.x), bflo(w.y), bfhi(w.y)}; x[j] = (f32x4){bflo(wx.x), bfhi(wx.x), bflo(wx.y), bfhi(wx.y)};
                ss += (rw[j][0] * rw[j][0] + rw[j][1] * rw[j][1]) + (rw[j][2] * rw[j][2] + rw[j][3] * rw[j][3]); }
            const float rstd1 = 1.0f / sqrtf(wave_sum(ss) * (1.0f / D) + EPS);
#pragma unroll
            for (int j = 0; j < 4; ++j) x[j] = x[j] + rw[j] * rstd1 * gp[j];
        }
        if (MODE == 2) {
#pragma unroll
            for (int j = 0; j < 4; ++j) *(f32x4*)(out + (size_t)row * D + 4 * F.lane + 256 * j) = x[j];
        } else {
            float ss = 0.f;
#pragma unroll
            for (int j = 0; j < 4; ++j) { v2u w; w.x = pk2(x[j][0], x[j][1]); w.y = pk2(x[j][2], x[j][3]); *(v2u*)(xb + (size_t)row * D + 4 * F.lane + 256 * j) = w;
                x[j] = (f32x4){bflo(w.x), bfhi(w.x), bflo(w.y), bfhi(w.y)};
                ss += (x[j][0] * x[j][0] + x[j][1] * x[j][1]) + (x[j][2] * x[j][2] + x[j][3] * x[j][3]); }
            const float rs2 = 1.0f / sqrtf(wave_sum(ss) * (1.0f / D) + EPS);
            if (F.lane == 0) rstd[row] = rs2;
            if (HAS_FF) {
                float ff[8];
#pragma unroll
                for (int j = 0; j < 4; ++j) x[j] = x[j] * rs2 * gq[j];
#pragma unroll
                for (int q = 0; q < 8; ++q) { float a = 0.f;
#pragma unroll
                    for (int j = 0; j < 4; ++j) { const f32x4 w = *(const LAS f32x4*)(wfT + q * D + 4 * F.lane + 256 * j); a += (x[j][0] * w[0] + x[j][1] * w[1]) + (x[j][2] * w[2] + x[j][3] * w[3]); }
                    ff[q] = wave_sum(a); }
                float mine = 0.f;
#pragma unroll
                for (int q = 0; q < 8; ++q) if (F.lane == q) mine = ff[q];
                if (F.lane < 8) { const float z = mine + bfox[F.lane]; const float lf = fminf(z, 0.f) - log1pf(expf(-fabsf(z)));
                    const int b = row / SEQ, t = row % SEQ; lfT[((size_t)b * 8 + F.lane) * SEQ + t] = lf; }
            }
        }
    }
}

template <int MODE>
__device__ __forceinline__ void thin4(Frame& F, const bf16* raw, const bf16* xb, bf16* xo, float* out, const float* gpost, float* rstd, const int rbeg, const int rend, const int gwl, const int ngw) {
    f32x4 gp[2][2];
#pragma unroll
    for (int s = 0; s < 2; ++s)
#pragma unroll
        for (int h = 0; h < 2; ++h) gp[s][h] = *(const f32x4*)(gpost + 512 * s + 8 * F.lane + 4 * h);
    for (int row0 = rbeg + gwl; row0 < rend; row0 += 4 * ngw) {
        v4u rw[4][2], xw[4][2];
#pragma unroll
        for (int r = 0; r < 4; ++r)
#pragma unroll
            for (int s = 0; s < 2; ++s) { const size_t o = (size_t)(row0 + r * ngw) * D + 512 * s + 8 * F.lane; rw[r][s] = *(const v4u*)(raw + o); xw[r][s] = *(const v4u*)(xb + o); }
        float ss[4];
#pragma unroll
        for (int r = 0; r < 4; ++r) { float a = 0.f;
#pragma unroll
            for (int s = 0; s < 2; ++s) { const v4u w = rw[r][s];
                a += ((bflo(w.x) * bflo(w.x) + bfhi(w.x) * bfhi(w.x)) + (bflo(w.y) * bflo(w.y) + bfhi(w.y) * bfhi(w.y))) + ((bflo(w.z) * bflo(w.z) + bfhi(w.z) * bfhi(w.z)) + (bflo(w.w) * bflo(w.w) + bfhi(w.w) * bfhi(w.w))); }
            ss[r] = a; }
#pragma unroll
        for (int o = 1; o < 64; o <<= 1)
#pragma unroll
            for (int r = 0; r < 4; ++r) ss[r] += __shfl_xor(ss[r], o);
        float s2[4];
#pragma unroll
        for (int r = 0; r < 4; ++r) { const float rs1 = 1.0f / sqrtf(ss[r] * (1.0f / D) + EPS); float a = 0.f; const size_t ro = (size_t)(row0 + r * ngw) * D;
#pragma unroll
            for (int s = 0; s < 2; ++s) { const v4u w = rw[r][s], wx = xw[r][s];
                const f32x4 y0 = (f32x4){bflo(wx.x), bfhi(wx.x), bflo(wx.y), bfhi(wx.y)} + (f32x4){bflo(w.x), bfhi(w.x), bflo(w.y), bfhi(w.y)} * rs1 * gp[s][0];
                const f32x4 y1 = (f32x4){bflo(wx.z), bfhi(wx.z), bflo(wx.w), bfhi(wx.w)} + (f32x4){bflo(w.z), bfhi(w.z), bflo(w.w), bfhi(w.w)} * rs1 * gp[s][1];
                if (MODE == 2) { *(f32x4*)(out + ro + 512 * s + 8 * F.lane) = y0; *(f32x4*)(out + ro + 512 * s + 8 * F.lane + 4) = y1; }
                else { v4u q; q.x = pk2(y0[0], y0[1]); q.y = pk2(y0[2], y0[3]); q.z = pk2(y1[0], y1[1]); q.w = pk2(y1[2], y1[3]); *(v4u*)(xo + ro + 512 * s + 8 * F.lane) = q;
                    a += ((bflo(q.x) * bflo(q.x) + bfhi(q.x) * bfhi(q.x)) + (bflo(q.y) * bflo(q.y) + bfhi(q.y) * bfhi(q.y))) + ((bflo(q.z) * bflo(q.z) + bfhi(q.z) * bfhi(q.z)) + (bflo(q.w) * bflo(q.w) + bfhi(q.w) * bfhi(q.w))); } }
            s2[r] = a; }
        if (MODE != 2) {
#pragma unroll
            for (int o = 1; o < 64; o <<= 1)
#pragma unroll
                for (int r = 0; r < 4; ++r) s2[r] += __shfl_xor(s2[r], o);
#pragma unroll
            for (int r = 0; r < 4; ++r) if (F.lane == r) rstd[row0 + r * ngw] = 1.0f / sqrtf(s2[r] * (1.0f / D) + EPS);
        }
    }
}

__device__ __forceinline__ void cscan_job(Frame& F, const float* lfT, float* c2, int bh) {
    LAS double* tot = (LAS double*)(F.lds + RING_OFF);
    const float* src = lfT + (size_t)bh * SEQ + 32 * F.tid; float* dst = c2 + (size_t)bh * SEQ + 32 * F.tid;
    float v[32];
#pragma unroll
    for (int j = 0; j < 8; ++j) { const f32x4 a = *(const f32x4*)(src + 4 * j); v[4 * j] = a[0]; v[4 * j + 1] = a[1]; v[4 * j + 2] = a[2]; v[4 * j + 3] = a[3]; }
#pragma unroll
    for (int j = 1; j < 32; ++j) v[j] += v[j - 1];
    double incl = (double)v[31];
#pragma unroll
    for (int o = 1; o < 64; o <<= 1) { const double t = __shfl_up(incl, o); if (F.lane >= o) incl += t; }
    if (F.lane == 63) tot[F.wave] = incl;
    __syncthreads();
    double off = incl - (double)v[31];
    for (int w = 0; w < F.wave; ++w) off += tot[w];
#pragma unroll
    for (int j = 0; j < 8; ++j) { f32x4 o; o[0] = (float)((off + (double)v[4 * j]) * 1.4426950408889634); o[1] = (float)((off + (double)v[4 * j + 1]) * 1.4426950408889634);
        o[2] = (float)((off + (double)v[4 * j + 2]) * 1.4426950408889634); o[3] = (float)((off + (double)v[4 * j + 3]) * 1.4426950408889634); *(f32x4*)(dst + 4 * j) = o; }
    __syncthreads();
}

__device__ __forceinline__ void lru_block_unit(Frame& F, int tile, int blk, const bf16* proj, const bf16x8 (&wgv)[2][2][4]  , bf16* ACout, bf16* HLout, float* carA, float* carH) {
    const LAS float* tab = (const LAS float*)(F.lds + LRU_TAB_OFF) + blk * 512;
    LAS unsigned char* X = F.lds + RING_OFF + F.wave * 16384;
    LAS unsigned char* TA = X + 5056; LAS unsigned char* TH = TA + 4608;
    const int r = F.lane & 31, h2 = F.lane >> 5;
    const int m0 = tile * 32, tl0 = m0 % SEQ;
#pragma unroll
    for (int i = 0; i < 5; ++i) { const int idx = F.lane + 64 * i, row = idx >> 3, chn = idx & 7;
        if (row < 35) { v4u v = (v4u){0u, 0u, 0u, 0u}; if (tl0 - 3 + row >= 0) v = *(const v4u*)(proj + (size_t)(m0 - 3 + row) * PTN + T_LX + 64 * blk + 8 * chn); *(LAS v4u*)(X + row * 144 + chn * 16) = v; } }
    LDS_WAIT(); asm volatile("" ::: "memory");
    bf16x8 xcf[4];
#pragma unroll
    for (int s = 0; s < 4; ++s) {
        const int cl = 16 * s + 8 * h2, cb = 64 * blk + cl;
        float xc[8];
        { const f32x4 b0 = *(const LAS f32x4*)(tab + 4 * 64 + cl), b1 = *(const LAS f32x4*)(tab + 4 * 64 + cl + 4); xc[0] = b0[0]; xc[1] = b0[1]; xc[2] = b0[2]; xc[3] = b0[3]; xc[4] = b1[0]; xc[5] = b1[1]; xc[6] = b1[2]; xc[7] = b1[3]; }
#pragma unroll
        for (int k = 0; k < 4; ++k) {
            const v4u w = *(const LAS v4u*)(X + (r + k) * 144 + cl * 2);
            const f32x4 c0 = *(const LAS f32x4*)(tab + k * 64 + cl), c1 = *(const LAS f32x4*)(tab + k * 64 + cl + 4);
            xc[0] += c0[0] * bflo(w.x); xc[1] += c0[1] * bfhi(w.x); xc[2] += c0[2] * bflo(w.y); xc[3] += c0[3] * bfhi(w.y);
            xc[4] += c1[0] * bflo(w.z); xc[5] += c1[1] * bfhi(w.z); xc[6] += c1[2] * bflo(w.w); xc[7] += c1[3] * bfhi(w.w);
        }
        v4u p; p.x = pk2(xc[0], xc[1]); p.y = pk2(xc[2], xc[3]); p.z = pk2(xc[4], xc[5]); p.w = pk2(xc[6], xc[7]);
        xcf[s] = __builtin_bit_cast(bf16x8, p);
    }
    f32x16 Gr[2], Gi[2];
#pragma unroll
    for (int jt = 0; jt < 2; ++jt) { Gr[jt] = (f32x16){}; Gi[jt] = (f32x16){}; }
    __builtin_amdgcn_s_setprio(1);
#pragma unroll
    for (int jt = 0; jt < 2; ++jt)
#pragma unroll
        for (int s = 0; s < 4; ++s) {
            const bf16x8 wr_ = wgv[0][jt][s], wi_ = wgv[1][jt][s];
            Gr[jt] = MFMA32(xcf[s], wr_, Gr[jt]); Gi[jt] = MFMA32(xcf[s], wi_, Gi[jt]);
        }
    __builtin_amdgcn_s_setprio(0);
#pragma unroll
    for (int jt = 0; jt < 2; ++jt) {
        const int cl = 32 * jt + r, ch = 64 * blk + cl;
        const float cw0 = tab[0 * 64 + cl], cw1 = tab[1 * 64 + cl], cw2 = tab[2 * 64 + cl], cw3 = tab[3 * 64 + cl], cbias = tab[4 * 64 + cl], br = tab[5 * 64 + cl], bi = tab[6 * 64 + cl], s8 = tab[7 * 64 + cl];
        float aa[16], hh[16];
#pragma unroll
        for (int g = 0; g < 4; ++g) {
            const int t0 = 8 * g + 4 * h2;
            float xr[7];
#pragma unroll
            for (int j = 0; j < 7; ++j) xr[j] = bflo((unsigned)*(const LAS unsigned short*)(X + (t0 + j) * 144 + cl * 2));
#pragma unroll
            for (int i = 0; i < 4; ++i) {
                const float xc = cbias + cw0 * xr[i] + cw1 * xr[i + 1] + cw2 * xr[i + 2] + cw3 * xr[i + 3];
                const float rg = sigmoidf_(Gr[jt][4 * g + i] + br), ig = sigmoidf_(Gi[jt][4 * g + i] + bi);
                const float la = -rg * s8; const float a = __builtin_amdgcn_exp2f(LOG2E * la);
                aa[4 * g + i] = a; hh[4 * g + i] = __builtin_amdgcn_sqrtf(fmaxf(fmaf(-a, a, 1.0f), 0.f)) * (ig * xc);
            }
#pragma unroll
            for (int i = 1; i < 4; ++i) { hh[4 * g + i] = aa[4 * g + i] * hh[4 * g + i - 1] + hh[4 * g + i]; aa[4 * g + i] = aa[4 * g + i] * aa[4 * g + i - 1]; }
        }
        float inA[4], inH[4], pa_[4], ph_[4];
#pragma unroll
        for (int g = 0; g < 4; ++g) {
            const v2u ra = __builtin_amdgcn_permlane32_swap(__float_as_uint(aa[4 * g + 3]), __float_as_uint(aa[4 * g + 3]), false, false);
            const v2u rh = __builtin_amdgcn_permlane32_swap(__float_as_uint(hh[4 * g + 3]), __float_as_uint(hh[4 * g + 3]), false, false);
            pa_[g] = __uint_as_float(h2 ? ra.x : ra.y); ph_[g] = __uint_as_float(h2 ? rh.x : rh.y); }
        float cA = 1.0f, cH = 0.f;
#pragma unroll
        for (int g = 0; g < 4; ++g) {
            const float a1 = h2 == 0 ? aa[4 * g + 3] : pa_[g], h1 = h2 == 0 ? hh[4 * g + 3] : ph_[g];
            const float a2 = h2 == 0 ? pa_[g] : aa[4 * g + 3], hx = h2 == 0 ? ph_[g] : hh[4 * g + 3];
            const float mA = a1 * cA, mH = a1 * cH + h1;
            inA[g] = h2 == 0 ? cA : mA; inH[g] = h2 == 0 ? cH : mH;
            cA = a2 * mA; cH = a2 * mH + hx; }
        if (h2 == 1) { carA[(size_t)tile * 256 + ch] = cA; carH[(size_t)tile * 256 + ch] = cH; }
#pragma unroll
        for (int reg = 0; reg < 16; ++reg) { const int g = reg >> 2, t = (reg & 3) + 8 * g + 4 * h2;
            const float hf = hh[reg] + aa[reg] * inH[g], af = aa[reg] * inA[g];
            *(LAS unsigned short*)(TA + t * 144 + cl * 2) = (unsigned short)(pk2(af, 0.f) & 0xffffu); *(LAS unsigned short*)(TH + t * 144 + cl * 2) = (unsigned short)(pk2(hf, 0.f) & 0xffffu); }
    }
    LDS_WAIT(); asm volatile("" ::: "memory");
#pragma unroll
    for (int i = 0; i < 4; ++i) { const int idx = F.lane + 64 * i, row = idx >> 3, chn = idx & 7;
        const v4u va = *(const LAS v4u*)(TA + row * 144 + chn * 16), vh = *(const LAS v4u*)(TH + row * 144 + chn * 16);
        *(v4u*)(ACout + (size_t)(m0 + row) * 256 + 64 * blk + 8 * chn) = va; *(v4u*)(HLout + (size_t)(m0 + row) * 256 + 64 * blk + 8 * chn) = vh; }
    LDS_WAIT(); asm volatile("" ::: "memory");
}

__device__ __forceinline__ float invfreq(int c, int e) {
    const float t[32] = {1.0f, 0.7498942017555237f, 0.5623413324356079f, 0.4216965138912201f, 0.3162277638912201f, 0.23713737726211548f, 0.17782793939113617f, 0.1333521455526352f,
        0.10000000149011612f, 0.0749894231557846f, 0.05623413249850273f, 0.04216964915394783f, 0.03162277489900589f, 0.023713737726211548f, 0.017782794311642647f, 0.013335213996469975f,
        0.009999999776482582f, 0.007498942315578461f, 0.005623413249850273f, 0.0042169648222625256f, 0.003162277629598975f, 0.0023713738191872835f, 0.0017782794311642647f, 0.0013335214462131262f,
        0.0010000000474974513f, 0.0007498941849917173f, 0.000562341301701963f, 0.0004216965171508491f, 0.0003162277571391314f, 0.00023713737027719617f, 0.00017782794020604342f, 0.0001333521504420787f};
    return c == 0 ? t[e] : c == 1 ? t[8 + e] : c == 2 ? t[16 + e] : t[24 + e];
}
__device__ __forceinline__ void prep_load(Frame& F, int tt, int jb, const bf16* pk, const bf16* pt, v4u (&w)[8]) {
    const int m0 = 64 * tt;
    if (jb < 8) {
        const int rr = F.lane >> 2, c = F.lane & 3; int scol, pitch = PTN; const bf16* proj = pt;
        if (jb < 4) { scol = K_RQ + 64 * jb; proj = pk; pitch = PKN; } else scol = T_RK + 64 * (jb - 4);
#pragma unroll
        for (int it = 0; it < 4; ++it) { const bf16* p = proj + (size_t)(m0 + 16 * it + rr) * pitch + scol + 8 * c; w[2 * it] = *(const v4u*)p; w[2 * it + 1] = *(const v4u*)(p + 32); }
    }
}
__device__ __forceinline__ void prep_unit(Frame& F, int tt, int jb, bf16* pk, const bf16* pt, const int* positions, bf16* rkf, bf16* kwf, bf16* rvf, bf16* fvT, const v4u (&wl)[8]) {
    LAS bf16* T = (LAS bf16*)(F.lds + RING_OFF + F.wave * 16384);
    const int m0 = 64 * tt, rr = F.lane >> 2, c = F.lane & 3;
    const int b_ = m0 / SEQ, t0 = (m0 % SEQ) / 32;
    int scol, h, pitch = PTN; bf16* proj = const_cast<bf16*>(pt);
    if (jb < 4) { h = jb; scol = K_RQ + 64 * h; proj = pk; pitch = PKN; }
    else { h = jb - 4; scol = T_RK + 64 * h; }
    const bool rot = jb < 8, isk = (jb >= 4 && jb < 8);
    const float lgk = lg2gamma(h);
#pragma unroll
    for (int it = 0; it < 4; ++it) {
        const int row = 16 * it + rr, m = m0 + row;
        bf16* p = proj + (size_t)m * pitch + scol + 8 * c;
        const v4u w1 = wl[2 * it], w2 = wl[2 * it + 1];
        float x1[8] = {bflo(w1.x), bfhi(w1.x), bflo(w1.y), bfhi(w1.y), bflo(w1.z), bfhi(w1.z), bflo(w1.w), bfhi(w1.w)};
        float x2[8] = {bflo(w2.x), bfhi(w2.x), bflo(w2.y), bfhi(w2.y), bflo(w2.z), bfhi(w2.z), bflo(w2.w), bfhi(w2.w)};
        float wt = 1.0f;
        if (rot) {
            const float pos = (float)positions[m];
#pragma unroll
            for (int e = 0; e < 8; ++e) {
                const float ang = pos * invfreq(c, e);
                const double rev = (double)ang * 0.15915494309189535; const float fr = (float)(rev - __builtin_rint(rev));
                const float sn = __builtin_amdgcn_sinf(fr), cs = __builtin_amdgcn_cosf(fr);
                const float a = x1[e], b = x2[e]; x1[e] = a * cs - b * sn; x2[e] = a * sn + b * cs;
            }
            if (isk) {
#pragma unroll
                for (int e = 0; e < 8; ++e) { x1[e] *= 0.125f; x2[e] *= 0.125f; }
                wt = __builtin_amdgcn_exp2f((float)(127 - (m & 127)) * lgk);
            }
            v4u o1, o2; o1.x = pk2(x1[0], x1[1]); o1.y = pk2(x1[2], x1[3]); o1.z = pk2(x1[4], x1[5]); o1.w = pk2(x1[6], x1[7]);
            o2.x = pk2(x2[0], x2[1]); o2.y = pk2(x2[2], x2[3]); o2.z = pk2(x2[4], x2[5]); o2.w = pk2(x2[6], x2[7]);
            if (!isk) { *(v4u*)p = o1; *(v4u*)(p + 32) = o2; }
            else {
                const int rl = swap23(row & 31); bf16* kb_ = rkf + ((size_t)((b_ * 4 + h) * 512 + t0 + (row >> 5)) * 4) * 512;
                *(v4u*)(kb_ + (size_t)((c >> 1) * 64 + rl + 32 * (c & 1)) * 8) = o1;
                *(v4u*)(kb_ + (size_t)((2 + (c >> 1)) * 64 + rl + 32 * (c & 1)) * 8) = o2;
            }
        }
        if (jb >= 4) {
#pragma unroll
            for (int e = 0; e < 8; ++e) { T[(8 * c + e) * 72 + row] = (bf16)(pk2(x1[e] * wt, 0.f) & 0xffffu); T[(32 + 8 * c + e) * 72 + row] = (bf16)(pk2(x2[e] * wt, 0.f) & 0xffffu); }
        }
    }
    if (jb >= 4) {
        LDS_WAIT(); asm volatile("" ::: "memory");
        const int r_ = F.lane & 31, h2_ = F.lane >> 5;
        if (jb >= 12) {
            bf16* vfb = fvT + ((size_t)((b_ * 8 + h) * 512 + t0) * 4) * 512 + F.lane * 8;
#pragma unroll
            for (int ti = 0; ti < 2; ++ti)
#pragma unroll
                for (int f = 0; f < 4; ++f) { const v4u v = *(const LAS v4u*)(T + (32 * (f >> 1) + r_) * 72 + 32 * ti + 16 * (f & 1) + 8 * h2_); *(v4u*)(vfb + (size_t)(ti * 4 + f) * 512) = v; }
        } else {
            const int n = t0 >> 2, half = (t0 >> 1) & 1;
            bf16* dst = (jb < 8 ? kwf : rvf) + ((size_t)((b_ * 128 + n) * 4 + h) * 16) * 512 + F.lane * 8;
#pragma unroll
            for (int xt = 0; xt < 2; ++xt)
#pragma unroll
                for (int sl = 0; sl < 4; ++sl) { const v4u v = *(const LAS v4u*)(T + (32 * xt + r_) * 72 + 16 * sl + 8 * h2_); *(v4u*)(dst + (size_t)(xt * 8 + 4 * half + sl) * 512) = v; }
        }
        LDS_WAIT(); asm volatile("" ::: "memory");
    }
}

__device__ __forceinline__ void kchunk_unit(Frame& F, int unit, const bf16* pt, const int* positions, bf16* rkf, const bf16* rvf, float* UT) {
    LAS bf16* T = (LAS bf16*)(F.lds + RING_OFF + F.wave * 16384);
    const int h = unit & 3, bn = unit >> 2, b_ = bn >> 7, n = bn & 127;
    const int rr = F.lane >> 2, c = F.lane & 3, r = F.lane & 31, h2 = F.lane >> 5;
    const float lgk = lg2gamma(h);
    f32x16 acc[2][2];
#pragma unroll
    for (int i = 0; i < 2; ++i)
#pragma unroll
        for (int j = 0; j < 2; ++j) acc[i][j] = (f32x16){};
    v4u wl[2][8]; int posv[2][4];
#pragma unroll
    for (int half = 0; half < 2; ++half)
#pragma unroll
        for (int it = 0; it < 4; ++it) { const int m = bn * 128 + 64 * half + 16 * it + rr; const bf16* p = pt + (size_t)m * PTN + T_RK + 64 * h + 8 * c;
            wl[half][2 * it] = *(const v4u*)p; wl[half][2 * it + 1] = *(const v4u*)(p + 32); posv[half][it] = positions[m]; }
#pragma unroll
    for (int half = 0; half < 2; ++half) {
        const int m0 = bn * 128 + 64 * half, t0 = 4 * n + 2 * half;
        bf16x8 afv[4][2];
#pragma unroll
        for (int sl = 0; sl < 4; ++sl)
#pragma unroll
            for (int i = 0; i < 2; ++i) afv[sl][i] = ld8(rvf + ((size_t)(unit * 2 + i) * 8 + 4 * half + sl) * 512 + F.lane * 8);
#pragma unroll
        for (int it = 0; it < 4; ++it) {
            const int row = 16 * it + rr, m = m0 + row;
            const v4u w1 = wl[half][2 * it], w2 = wl[half][2 * it + 1];
            float x1[8] = {bflo(w1.x), bfhi(w1.x), bflo(w1.y), bfhi(w1.y), bflo(w1.z), bfhi(w1.z), bflo(w1.w), bfhi(w1.w)};
            float x2[8] = {bflo(w2.x), bfhi(w2.x), bflo(w2.y), bfhi(w2.y), bflo(w2.z), bfhi(w2.z), bflo(w2.w), bfhi(w2.w)};
            const float pos = (float)posv[half][it];
#pragma unroll
            for (int e = 0; e < 8; ++e) {
                const float ang = pos * invfreq(c, e);
                const double rev = (double)ang * 0.15915494309189535; const float fr = (float)(rev - __builtin_rint(rev));
                const float sn = __builtin_amdgcn_sinf(fr), cs = __builtin_amdgcn_cosf(fr);
                const float a = x1[e], bb = x2[e]; x1[e] = (a * cs - bb * sn) * 0.125f; x2[e] = (a * sn + bb * cs) * 0.125f;
            }
            const float wt = __builtin_amdgcn_exp2f((float)(127 - (m & 127)) * lgk);
            v4u o1, o2; o1.x = pk2(x1[0], x1[1]); o1.y = pk2(x1[2], x1[3]); o1.z = pk2(x1[4], x1[5]); o1.w = pk2(x1[6], x1[7]);
            o2.x = pk2(x2[0], x2[1]); o2.y = pk2(x2[2], x2[3]); o2.z = pk2(x2[4], x2[5]); o2.w = pk2(x2[6], x2[7]);
            const int rl = swap23(row & 31); bf16* kb_ = rkf + ((size_t)((b_ * 4 + h) * 512 + t0 + (row >> 5)) * 4) * 512;
            *(v4u*)(kb_ + (size_t)((c >> 1) * 64 + rl + 32 * (c & 1)) * 8) = o1;
            *(v4u*)(kb_ + (size_t)((2 + (c >> 1)) * 64 + rl + 32 * (c & 1)) * 8) = o2;
#pragma unroll
            for (int e = 0; e < 8; ++e) { T[(8 * c + e) * 72 + row] = (bf16)(pk2(x1[e] * wt, 0.f) & 0xffffu); T[(32 + 8 * c + e) * 72 + row] = (bf16)(pk2(x2[e] * wt, 0.f) & 0xffffu); }
        }
        LDS_WAIT(); asm volatile("" ::: "memory");
#pragma unroll
        for (int sl = 0; sl < 4; ++sl) {
            bf16x8 af[2], bfr[2];
#pragma unroll
            for (int i = 0; i < 2; ++i) { af[i] = afv[sl][i]; bfr[i] = *(const LAS bf16x8*)(T + (32 * i + r) * 72 + 16 * sl + 8 * h2); }
#pragma unroll
            for (int et = 0; et < 2; ++et)
#pragma unroll
                for (int dt = 0; dt < 2; ++dt) acc[et][dt] = MFMA32(af[et], bfr[dt], acc[et][dt]);
        }
        LDS_WAIT(); asm volatile("" ::: "memory");
    }
    float* dst = UT + (size_t)unit * 4096;
#pragma unroll
    for (int et = 0; et < 2; ++et)
#pragma unroll
        for (int dt = 0; dt < 2; ++dt)
#pragma unroll
            for (int reg = 0; reg < 16; ++reg) dst[(32 * et + crow(reg, h2)) * 64 + 32 * dt + r] = acc[et][dt][reg];
}

__device__ __forceinline__ void fox_knorm_load(Frame& F, const bf16* kfr, v4u (&kn)[16], const int bi) {
#pragma unroll
    for (int k = 0; k < 4; ++k) { const int j = 32 * bi + 4 * F.wave + k; const bf16* src = kfr + (size_t)j * 4 * 512 + F.lane * 8;
#pragma unroll
        for (int s_ = 0; s_ < 4; ++s_) kn[4 * k + s_] = *(const v4u*)(src + (size_t)s_ * 512); }
}
__device__ __forceinline__ void fox_knorm_reduce(Frame& F, const v4u (&kn)[16], unsigned* kmax  , const int bi) {
    LAS float* red = (LAS float*)(F.lds + RING_OFF + 1024);
    float mx = 0.f;
#pragma unroll
    for (int k = 0; k < 4; ++k) { float sq = 0.f;
#pragma unroll
        for (int s_ = 0; s_ < 4; ++s_) { const v4u v = kn[4 * k + s_];
            sq += bflo(v.x) * bflo(v.x) + bfhi(v.x) * bfhi(v.x) + bflo(v.y) * bflo(v.y) + bfhi(v.y) * bfhi(v.y) + bflo(v.z) * bflo(v.z) + bfhi(v.z) * bfhi(v.z) + bflo(v.w) * bflo(v.w) + bfhi(v.w) * bfhi(v.w); }
        sq = sum_x32(sq); mx = fmaxf(mx, sq); }
    mx = max_over32(mx);
    if (F.lane == 0) red[F.wave] = mx;
    __syncthreads();
    if (F.tid == 0) { float m = red[0];
#pragma unroll
        for (int w = 1; w < 8; ++w) m = fmaxf(m, red[w]);
        atomicMax(kmax + (bi >> 4), __float_as_uint(m * 1.0001f)); }
    __syncthreads();
}

__device__ __forceinline__ void ret_state_unit(Frame& F, int unit, const bf16* rvT, const bf16* kwT, float* UT) {
    const int r = F.lane & 31, h2 = F.lane >> 5; const int h = unit & 3, bn = unit >> 2; const size_t m0 = (size_t)bn * 128;
    f32x16 acc[2][2];
#pragma unroll
    for (int i = 0; i < 2; ++i)
#pragma unroll
        for (int j = 0; j < 2; ++j) acc[i][j] = (f32x16){};
#pragma unroll
    for (int s = 0; s < 8; ++s) {
        bf16x8 af[2], bfr[2];
#pragma unroll
        for (int i = 0; i < 2; ++i) { af[i] = ld8(rvT + ((size_t)(unit * 2 + i) * 8 + s) * 512 + F.lane * 8); bfr[i] = ld8(kwT + ((size_t)(unit * 2 + i) * 8 + s) * 512 + F.lane * 8); }
#pragma unroll
        for (int et = 0; et < 2; ++et)
#pragma unroll
            for (int dt = 0; dt < 2; ++dt) acc[et][dt] = MFMA32(af[et], bfr[dt], acc[et][dt]);
    }
    float* dst = UT + (size_t)unit * 4096;
#pragma unroll
    for (int et = 0; et < 2; ++et)
#pragma unroll
        for (int dt = 0; dt < 2; ++dt)
#pragma unroll
            for (int reg = 0; reg < 16; ++reg) dst[(32 * et + crow(reg, h2)) * 64 + 32 * dt + r] = acc[et][dt][reg];
}

__device__ __forceinline__ void lru_carry_scan_wave(Frame& F, int seq, const float* carA, const float* carH, float* carIn) {
    const int b = seq >> 8, ch = seq & 255; const size_t base = ((size_t)b * 512 + 8 * F.lane) * 256 + ch;
    float a[8], hh[8];
#pragma unroll
    for (int j = 0; j < 8; ++j) { a[j] = carA[base + (size_t)j * 256]; hh[j] = carH[base + (size_t)j * 256]; }
    float Al = a[0], Hl = hh[0];
#pragma unroll
    for (int j = 1; j < 8; ++j) { Hl = a[j] * Hl + hh[j]; Al *= a[j]; }
#pragma unroll
    for (int d = 1; d < 64; d <<= 1) { const float Ap = __shfl_up(Al, d), Hp = __shfl_up(Hl, d); if (F.lane >= d) { Hl = Al * Hp + Hl; Al = Al * Ap; } }
    float c = __shfl_up(Hl, 1); if (F.lane == 0) c = 0.f;
#pragma unroll
    for (int j = 0; j < 8; ++j) { carIn[base + (size_t)j * 256] = c; c = a[j] * c + hh[j]; }
}
__device__ __forceinline__ void lru_carry_scan_wg(Frame& F, int g, const float* carA, const float* carH, float* carIn) {
    LAS float* sA = (LAS float*)(F.lds + RING_OFF); LAS float* sH = sA + 16 * 512;
    const int b = g >> 4, c0 = (g & 15) * 16, t = F.tid;
    const size_t rowo = ((size_t)b * 512 + t) * 256 + c0;
    f32x4 va[4], vh[4];
#pragma unroll
    for (int q = 0; q < 4; ++q) { va[q] = *(const f32x4*)(carA + rowo + 4 * q); vh[q] = *(const f32x4*)(carH + rowo + 4 * q); }
#pragma unroll
    for (int q = 0; q < 4; ++q)
#pragma unroll
        for (int e = 0; e < 4; ++e) { const int c = 4 * q + e, idx = c * 512 + (t ^ ((c & 7) << 2)); sA[idx] = va[q][e]; sH[idx] = vh[q][e]; }
    __syncthreads();
#pragma unroll
    for (int s_ = 0; s_ < 2; ++s_) {
        const int c = 2 * F.wave + s_, k = (c & 7) << 2; LAS float* pa = sA + c * 512, * ph = sH + c * 512;
        const f32x4 a0 = *(const LAS f32x4*)(pa + ((8 * F.lane) ^ k)), a1 = *(const LAS f32x4*)(pa + ((8 * F.lane + 4) ^ k));
        const f32x4 h0 = *(const LAS f32x4*)(ph + ((8 * F.lane) ^ k)), h1 = *(const LAS f32x4*)(ph + ((8 * F.lane + 4) ^ k));
        const float a[8] = {a0[0], a0[1], a0[2], a0[3], a1[0], a1[1], a1[2], a1[3]}, hh[8] = {h0[0], h0[1], h0[2], h0[3], h1[0], h1[1], h1[2], h1[3]};
        float Al = a[0], Hl = hh[0];
#pragma unroll
        for (int j = 1; j < 8; ++j) { Hl = a[j] * Hl + hh[j]; Al *= a[j]; }
#pragma unroll
        for (int d = 1; d < 64; d <<= 1) { const float Ap = __shfl_up(Al, d), Hp = __shfl_up(Hl, d); if (F.lane >= d) { Hl = Al * Hp + Hl; Al = Al * Ap; } }
        float cin = __shfl_up(Hl, 1); if (F.lane == 0) cin = 0.f;
        f32x4 o0, o1;
#pragma unroll
        for (int j = 0; j < 8; ++j) { if (j < 4) o0[j] = cin; else o1[j - 4] = cin; cin = a[j] * cin + hh[j]; }
        *(LAS f32x4*)(pa + ((8 * F.lane) ^ k)) = o0; *(LAS f32x4*)(pa + ((8 * F.lane + 4) ^ k)) = o1;
    }
    __syncthreads();
#pragma unroll
    for (int q = 0; q < 4; ++q) { f32x4 o;
#pragma unroll
        for (int e = 0; e < 4; ++e) { const int c = 4 * q + e; o[e] = sA[c * 512 + (t ^ ((c & 7) << 2))]; }
        *(f32x4*)(carIn + rowo + 4 * q) = o; }
    __syncthreads();
}
__device__ __forceinline__ void ret_state_scan_wg(Frame& F, const float* UT, bf16* PREV, const int bi) {
    LAS float* E = (LAS float*)(F.lds + RING_OFF);
    const int sl = F.tid & 127, part = F.tid >> 7; const int gid = bi * 128 + sl;
    const int b = gid >> 14, h = (gid >> 12) & 3, ed = gid & 4095;
    const float g1 = __builtin_amdgcn_exp2f(128.f * lg2gamma(h));
    float u[32];
#pragma unroll
    for (int k = 0; k < 32; ++k) u[k] = UT[((size_t)(b * 128 + 32 * part + k) * 4 + h) * 4096 + ed];
    float st = 0.f;
#pragma unroll
    for (int k = 0; k < 32; ++k) { const float t = u[k]; u[k] = st; st = g1 * st + t; }
    E[part * 128 + sl] = st;
    __syncthreads();
    float g32 = g1;
#pragma unroll
    for (int i = 0; i < 5; ++i) g32 *= g32;
    float c = 0.f;
    for (int pp = 0; pp < part; ++pp) c = g32 * c + E[pp * 128 + sl];
    float gk = 1.0f;
#pragma unroll
    for (int k = 0; k < 32; ++k) { PREV[((size_t)(b * 128 + 32 * part + k) * 4 + h) * 4096 + ed] = (bf16)(pk2(u[k] + gk * c, 0.f) & 0xffffu); gk *= g1; }
    __syncthreads();
}

__device__ __forceinline__ void fox_stage(Frame& F, const bf16* kbh, const bf16* vbh, const float* cc, int T_lo, int n, int s0, int s1, bool with_c) {
    LAS unsigned char* stg = F.lds + RING_OFF;
    for (int j = 8 * s0 + F.wave; j < s1 * 8; j += NWAVES) { const int s_ = j >> 3, f = j & 7;
        const bf16* src = (f < 4 ? kbh + ((size_t)(T_lo + s_) * 4 + f) * 512 : vbh + ((size_t)(T_lo + s_) * 4 + (f - 4)) * 512) + F.lane * 8;
        __builtin_amdgcn_global_load_lds((const unsigned*)src, (LAS unsigned*)(stg + (size_t)j * 1024), 16, 0, 0); }
    if (with_c && F.tid < n * 8) *(LAS f32x4*)(F.lds + LRU_TAB_OFF + F.tid * 16) = *(const f32x4*)(cc + 32 * T_lo + 4 * F.tid);
}
__device__ __forceinline__ void fox_unit(Frame& F, int b, int h, int qt, const bf16* proj, const bf16* kfr, const bf16* fvT, const float* c2, bf16* mix, const unsigned* kmax, const int T_lo, const int nst, const bf16* nxk, const bf16* nxv) {
    const int r = F.lane & 31, h2 = F.lane >> 5;
    const size_t mb = (size_t)b * SEQ; const int q0 = 32 * qt;
    const float* cc = c2 + ((size_t)b * 8 + h) * SEQ;
    bf16x8 qf[4];
#pragma unroll
    for (int s = 0; s < 4; ++s) qf[s] = ld8(proj + (mb + q0 + r) * PKN + K_FQ + 64 * h + 16 * s + 8 * h2);
    const float cq = cc[q0 + r], cq0 = cc[q0];
    const unsigned kmx = kmax[b * 8 + h];
    const int tw = qt - 1 - F.lane; const float cend = cc[32 * (tw > 0 ? tw : 0) + 31];
    asm volatile("s_waitcnt vmcnt(0)" ::: "memory");
    __syncthreads();
    const LAS unsigned char* stg = F.lds + RING_OFF + F.lane * 16; const LAS unsigned char* cl = F.lds + LRU_TAB_OFF + (8 * h2) * 4;
    float qn = 0.f;
#pragma unroll
    for (int s = 0; s < 4; ++s) { const v4u w = __builtin_bit_cast(v4u, qf[s]);
        qn += bflo(w.x) * bflo(w.x) + bfhi(w.x) * bfhi(w.x) + bflo(w.y) * bflo(w.y) + bfhi(w.y) * bfhi(w.y) + bflo(w.z) * bflo(w.z) + bfhi(w.z) * bfhi(w.z) + bflo(w.w) * bflo(w.w) + bfhi(w.w) * bfhi(w.w); }
    qn = sum_x32(qn);
    qn = max_over32(qn);
    const float smax = sqrtf(qn * 1.0001f) * sqrtf(__uint_as_float(kmx)) * 1.0001f;
    float mrow = -1e30f, lsum = 0.f;
    f32x16 o[2]; o[0] = (f32x16){}; o[1] = (f32x16){};
    const bf16* kbase = kfr + ((size_t)(b * 8 + h) * 512 * 4) * 512 + F.lane * 8;
    const bf16* vbase = fvT + ((size_t)(b * 8 + h) * 512 * 4) * 512 + F.lane * 8;
    bf16x8 kA[4], vA[4], kB[4], vB[4]; f32x4 cA[4], cB[4];
#define FOX_LOAD(KF, VF, CK, t_) do { const int t__ = (t_) > 0 ? (t_) : 0; \
        _Pragma("unroll") for (int s = 0; s < 4; ++s) { KF[s] = ld8(kbase + (size_t)(t__ * 4 + s) * 512); VF[s] = ld8(vbase + (size_t)(t__ * 4 + s) * 512); } \
        _Pragma("unroll") for (int g = 0; g < 4; ++g) CK[g] = *(const f32x4*)(cc + 32 * t__ + 16 * (g >> 1) + 8 * h2 + 4 * (g & 1)); } while (0)
#define FOX_LDS(KF, VF, CK, t_) do { const int s__ = (t_) - T_lo > 0 ? (t_) - T_lo : 0; \
        _Pragma("unroll") for (int s = 0; s < 4; ++s) { KF[s] = *(const LAS bf16x8*)(stg + s__ * 8192 + s * 1024); VF[s] = *(const LAS bf16x8*)(stg + s__ * 8192 + 4096 + s * 1024); } \
        _Pragma("unroll") for (int g = 0; g < 4; ++g) CK[g] = *(const LAS f32x4*)(cl + s__ * 128 + (16 * (g >> 1) + 4 * (g & 1)) * 4); } while (0)
#define FOX_TILE(KF, VF, CK, DIAG) do { \
        f32x16 sc = (f32x16){}; \
        _Pragma("unroll") for (int s = 0; s < 4; ++s) sc = MFMA32(KF[s], qf[s], sc); \
        float mx = -1e30f; \
        _Pragma("unroll") for (int reg = 0; reg < 16; ++reg) { float x = sc[reg] + (cq - CK[reg >> 2][reg & 3]); \
            if (DIAG) { const int key = 16 * (reg >> 3) + 8 * h2 + (reg & 7); if (key > r) x = -1e30f; } \
            sc[reg] = x; mx = fmaxf(mx, x); } \
        mx = max_x32(mx); \
        const float mnew = fmaxf(mrow, mx); \
        if (__any(mnew > mrow)) { const float al = __builtin_amdgcn_exp2f(mrow - mnew); lsum *= al; \
            _Pragma("unroll") for (int reg = 0; reg < 16; ++reg) { o[0][reg] *= al; o[1][reg] *= al; } \
            mrow = mnew; } \
        float ps = 0.f; \
        _Pragma("unroll") for (int reg = 0; reg < 16; ++reg) { const float p = __builtin_amdgcn_exp2f(sc[reg] - mrow); sc[reg] = p; ps += p; } \
        lsum += ps; \
        const bf16x8 p0 = pack8(sc, 0), p1 = pack8(sc, 1); \
        o[0] = MFMA32(VF[0], p0, o[0]); o[0] = MFMA32(VF[1], p1, o[0]); \
        o[1] = MFMA32(VF[2], p0, o[1]); o[1] = MFMA32(VF[3], p1, o[1]); } while (0)
    FOX_LDS(kA, vA, cA, qt); if (F.wave > 0) FOX_LDS(kB, vB, cB, qt - 1);
    fox_stage(F, kbase - F.lane * 8, vbase - F.lane * 8, cc, T_lo, nst, 0, nst - 8, false);
    FOX_TILE(kA, vA, cA, true);
    int rem = 0;
    { float mm = mrow;
      mm = min_over32(mm);
      const float thr = mm - FOX_T2;
      for (int base = qt - 1; base >= 0; base -= 64) { const int t = base - F.lane; bool alive = false;
          if (t >= 0) alive = !(smax + cq0 - (base == qt - 1 ? cend : cc[32 * t + 31]) < thr);
          const int n = __popcll(__ballot(alive)); rem += n; if (n < 64) break; } }
    asm volatile("s_waitcnt vmcnt(0)" ::: "memory"); __syncthreads();
    if (F.wave == 0) FOX_LDS(kB, vB, cB, qt - 1);
    if (nxk) {
        LAS unsigned* dummy = (LAS unsigned*)(F.lds + LRU_TAB_OFF + 4352 + F.wave * 256);
        const char* pk_ = (const char*)nxk + (size_t)(F.wave * 64 + F.lane) * 128; const char* pv_ = (const char*)nxv + (size_t)(F.wave * 64 + F.lane) * 128;
        __builtin_amdgcn_global_load_lds((const unsigned*)pk_, dummy, 4, 0, 0); __builtin_amdgcn_global_load_lds((const unsigned*)pv_, dummy, 4, 0, 0); }
    int kt = qt - 1;
    int nl = kt - T_lo + 1; nl = nl < rem ? nl : rem; rem -= nl;
    if (smax <= 48.0f) {
        f32x16 cinit;
#pragma unroll
        for (int reg = 0; reg < 16; ++reg) cinit[reg] = cq - mrow;
#define FOX_TILE_FAST(KF, VF, CK) do { \
        f32x16 sc = cinit; \
        __builtin_amdgcn_s_setprio(1); \
        _Pragma("unroll") for (int s = 0; s < 4; ++s) sc = MFMA32(KF[s], qf[s], sc); \
        __builtin_amdgcn_s_setprio(0); \
        float ps = 0.f; \
        _Pragma("unroll") for (int reg = 0; reg < 16; ++reg) { const float p_ = __builtin_amdgcn_exp2f(sc[reg] - CK[reg >> 2][reg & 3]); sc[reg] = p_; ps += p_; } \
        lsum += ps; \
        const bf16x8 p0 = pack8(sc, 0), p1 = pack8(sc, 1); \
        __builtin_amdgcn_s_setprio(1); \
        o[0] = MFMA32(VF[0], p0, o[0]); o[0] = MFMA32(VF[1], p1, o[0]); \
        o[1] = MFMA32(VF[2], p0, o[1]); o[1] = MFMA32(VF[3], p1, o[1]); \
        __builtin_amdgcn_s_setprio(0); } while (0)
        while (nl > 0) {
            FOX_LDS(kA, vA, cA, kt - 1); FOX_TILE_FAST(kB, vB, cB); --kt; if (--nl == 0) break;
            FOX_LDS(kB, vB, cB, kt - 1); FOX_TILE_FAST(kA, vA, cA); --kt; --nl;
        }
        if (rem > 0) {
            FOX_LOAD(kB, vB, cB, kt);
            while (rem > 0) {
                FOX_LOAD(kA, vA, cA, kt - 1); FOX_TILE_FAST(kB, vB, cB); --kt; if (--rem == 0) break;
                FOX_LOAD(kB, vB, cB, kt - 1); FOX_TILE_FAST(kA, vA, cA); --kt; --rem;
            }
        }
#undef FOX_TILE_FAST
    } else {
        while (nl > 0) {
            FOX_LDS(kA, vA, cA, kt - 1); FOX_TILE(kB, vB, cB, false); --kt; if (--nl == 0) break;
            FOX_LDS(kB, vB, cB, kt - 1); FOX_TILE(kA, vA, cA, false); --kt; --nl;
        }
        if (rem > 0) {
            FOX_LOAD(kB, vB, cB, kt);
            while (rem > 0) {
                FOX_LOAD(kA, vA, cA, kt - 1); FOX_TILE(kB, vB, cB, false); --kt; if (--rem == 0) break;
                FOX_LOAD(kB, vB, cB, kt - 1); FOX_TILE(kA, vA, cA, false); --kt; --rem;
            }
        }
    }
#undef FOX_LOAD
#undef FOX_LDS
#undef FOX_TILE
    lsum = sum_x32(lsum);
    const float inv = 1.0f / lsum;
    bf16* op = mix + (mb + q0 + r) * D + 256 + 64 * h;
#pragma unroll
    for (int et = 0; et < 2; ++et)
#pragma unroll
        for (int p_ = 0; p_ < 2; ++p_) {
            const int g = 2 * p_; v2u wa, wb; wa.x = pk2(o[et][4 * g] * inv, o[et][4 * g + 1] * inv); wa.y = pk2(o[et][4 * g + 2] * inv, o[et][4 * g + 3] * inv);
            wb.x = pk2(o[et][4 * g + 4] * inv, o[et][4 * g + 5] * inv); wb.y = pk2(o[et][4 * g + 6] * inv, o[et][4 * g + 7] * inv);
            const v2u rx = __builtin_amdgcn_permlane32_swap(wa.x, wb.x, false, false), ry = __builtin_amdgcn_permlane32_swap(wa.y, wb.y, false, false);
            *(v4u*)(op + 32 * et + 16 * p_ + 8 * h2) = (v4u){rx.x, ry.x, rx.y, ry.y}; }
}

__device__ __forceinline__ float gelu_tanh(float x) { const float u = 0.7978845608028654f * (x + 0.044715f * x * x * x); const float t = 1.0f - 2.0f * __builtin_amdgcn_rcpf(1.0f + __builtin_amdgcn_exp2f(2.0f * LOG2E * u)); return 0.5f * x * (1.0f + t); }
__device__ __forceinline__ void lru_final(Frame& F, const bf16* AC, const bf16* HL, const float* carIn, const bf16* proj, bf16* mix) {
    for (int it = blockIdx.x * (NWAVES * 64) + F.tid; it < M * 32; it += F.G * NWAVES * 64) {
        const int m = it >> 5, ch = (it & 31) * 8;
        const v4u wa = *(const v4u*)(AC + (size_t)m * 256 + ch), wh = *(const v4u*)(HL + (size_t)m * 256 + ch), wy = *(const v4u*)(proj + (size_t)m * PKN + K_LY + ch);
        const float* cp = carIn + (size_t)(m >> 5) * 256 + ch; const f32x4 c0 = *(const f32x4*)cp, c1 = *(const f32x4*)(cp + 4);
        float o[8];
        o[0] = (bflo(wh.x) + bflo(wa.x) * c0[0]) * gelu_tanh(bflo(wy.x)); o[1] = (bfhi(wh.x) + bfhi(wa.x) * c0[1]) * gelu_tanh(bfhi(wy.x));
        o[2] = (bflo(wh.y) + bflo(wa.y) * c0[2]) * gelu_tanh(bflo(wy.y)); o[3] = (bfhi(wh.y) + bfhi(wa.y) * c0[3]) * gelu_tanh(bfhi(wy.y));
        o[4] = (bflo(wh.z) + bflo(wa.z) * c1[0]) * gelu_tanh(bflo(wy.z)); o[5] = (bfhi(wh.z) + bfhi(wa.z) * c1[1]) * gelu_tanh(bfhi(wy.z));
        o[6] = (bflo(wh.w) + bflo(wa.w) * c1[2]) * gelu_tanh(bflo(wy.w)); o[7] = (bfhi(wh.w) + bfhi(wa.w) * c1[3]) * gelu_tanh(bfhi(wy.w));
        v4u w; w.x = pk2(o[0], o[1]); w.y = pk2(o[2], o[3]); w.z = pk2(o[4], o[5]); w.w = pk2(o[6], o[7]);
        *(v4u*)(mix + (size_t)m * D + ch) = w;
    }
}
__device__ __forceinline__ void rows_to_lds(const bf16* g0, size_t row_stride, int nrows, LAS unsigned char* dst, int lane) {
    for (int i = 0; i < nrows / 8; ++i) { const int row = 8 * i + (lane >> 3), c16 = lane & 7;
        const v4u v = *(const v4u*)(g0 + (size_t)row * row_stride + c16 * 8); *(LAS v4u*)(dst + row * 144 + c16 * 16) = v; }
}
__device__ __forceinline__ void ret_final_unit(Frame& F, int unit, const bf16* proj, const bf16* rkf, const bf16* rvT, const bf16* PREV, bf16* mix) {
    const int r = F.lane & 31, h2 = F.lane >> 5; const int h = unit & 3, bq = unit >> 2, qt = bq & 511, b = bq >> 9;
    const int n = qt >> 2, qi = qt & 3; const size_t mb = (size_t)b * SEQ, mc = mb + 128 * n, m0 = mb + 32 * qt;
    const float lg = lg2gamma(h);
    LAS unsigned char* LA = F.lds + RING_OFF + F.wave * 16384; LAS unsigned char* LB = LA + 4608;
    rows_to_lds(proj + m0 * PKN + K_RQ + 64 * h, PKN, 32, LA, F.lane);
    rows_to_lds(PREV + ((size_t)(b * 128 + n) * 4 + h) * 4096, 64, 64, LB, F.lane);
    LDS_WAIT(); asm volatile("" ::: "memory");
    bf16x8 qf[4], sf[2][4];
#pragma unroll
    for (int s = 0; s < 4; ++s) qf[s] = *(const LAS bf16x8*)(LA + r * 144 + (16 * s + 8 * h2) * 2);
#pragma unroll
    for (int et = 0; et < 2; ++et)
#pragma unroll
        for (int s = 0; s < 4; ++s) sf[et][s] = *(const LAS bf16x8*)(LB + (32 * et + r) * 144 + (16 * s + 8 * h2) * 2);
    LDS_WAIT(); asm volatile("" ::: "memory");
    rows_to_lds(proj + m0 * PKN + K_RG + 64 * h, PKN, 32, LA, F.lane);
    f32x16 y[2]; y[0] = (f32x16){}; y[1] = (f32x16){};
    for (int kt = 0; kt <= qi; ++kt) {
        f32x16 sc = (f32x16){};
        bf16x8 kf_[4];
#pragma unroll
        for (int s = 0; s < 4; ++s) kf_[s] = ld8(rkf + ((size_t)((b * 4 + h) * 512 + 4 * n + kt) * 4 + s) * 512 + F.lane * 8);
        __builtin_amdgcn_s_setprio(1);
#pragma unroll
        for (int s = 0; s < 4; ++s) sc = MFMA32(kf_[s], qf[s], sc);
        __builtin_amdgcn_s_setprio(0);
#pragma unroll
        for (int reg = 0; reg < 16; ++reg) { const int j = 32 * kt + 16 * (reg >> 3) + 8 * h2 + (reg & 7), i = 32 * qi + r, df = i - j;
            sc[reg] = df >= 0 ? sc[reg] * __builtin_amdgcn_exp2f((float)df * lg) : 0.f; }
        const bf16x8 p0 = pack8(sc, 0), p1 = pack8(sc, 1);
        bf16x8 vf_[4];
#pragma unroll
        for (int et = 0; et < 2; ++et) { const bf16* vp = rvT + ((size_t)(((b * 128 + n) * 4 + h) * 2 + et) * 8 + 2 * kt) * 512 + F.lane * 8; vf_[2 * et] = ld8(vp); vf_[2 * et + 1] = ld8(vp + 512); }
        __builtin_amdgcn_s_setprio(1);
#pragma unroll
        for (int et = 0; et < 2; ++et) { y[et] = MFMA32(vf_[2 * et], p0, y[et]); y[et] = MFMA32(vf_[2 * et + 1], p1, y[et]); }
        __builtin_amdgcn_s_setprio(0);
    }
    (void)mc;
    const float qw = __builtin_amdgcn_exp2f((float)(32 * qi + r + 1) * lg);
    float s1 = 0.f;
#pragma unroll
    for (int et = 0; et < 2; ++et) { f32x16 yc = (f32x16){};
#pragma unroll
        for (int s = 0; s < 4; ++s) yc = MFMA32(sf[et][s], qf[s], yc);
#pragma unroll
        for (int reg = 0; reg < 16; ++reg) { y[et][reg] += qw * yc[reg]; s1 += y[et][reg]; } }
    s1 = sum_x32(s1);
    const float mu = s1 * (1.0f / 64.0f); float s2 = 0.f;
#pragma unroll
    for (int et = 0; et < 2; ++et)
#pragma unroll
        for (int reg = 0; reg < 16; ++reg) { const float d = y[et][reg] - mu; s2 += d * d; }
    s2 = sum_x32(s2);
    const float rs = 1.0f / sqrtf(s2 * (1.0f / 64.0f) + EPS);
    LDS_WAIT(); asm volatile("" ::: "memory");
#pragma unroll
    for (int et = 0; et < 2; ++et)
#pragma unroll
        for (int g = 0; g < 4; ++g) { LAS unsigned char* pe = LA + r * 144 + (32 * et + 8 * g + 4 * h2) * 2; const v2u gw = *(const LAS v2u*)pe;
            const float g0 = bflo(gw.x), g1 = bfhi(gw.x), g2 = bflo(gw.y), g3 = bfhi(gw.y);
            v2u w; w.x = pk2(g0 * sigmoidf_(g0) * (y[et][4 * g] - mu) * rs, g1 * sigmoidf_(g1) * (y[et][4 * g + 1] - mu) * rs);
            w.y = pk2(g2 * sigmoidf_(g2) * (y[et][4 * g + 2] - mu) * rs, g3 * sigmoidf_(g3) * (y[et][4 * g + 3] - mu) * rs);
            *(LAS v2u*)pe = w; }
    LDS_WAIT(); asm volatile("" ::: "memory");
    bf16* op = mix + m0 * D + 768 + 64 * h;
#pragma unroll
    for (int i = 0; i < 4; ++i) { const int row = 8 * i + (F.lane >> 3), c16 = F.lane & 7; *(v4u*)(op + (size_t)row * D + c16 * 8) = *(const LAS v4u*)(LA + row * 144 + c16 * 16); }
    LDS_WAIT(); asm volatile("" ::: "memory");
}


typedef const __attribute__((address_space(4))) Args* kargs_t;
#define KARGS() ({ kargs_t _p = (kargs_t)__builtin_amdgcn_kernarg_segment_ptr(); asm volatile("" : "+s"(_p)); _p; })
#define IN_F(i) ((const float*)ap->in[i])
#define x_in IN_F(0)
#define mem IN_F(1)
#define positions ((const int*)ap->in[2])
#define pre_mix_g IN_F(3)
#define post_mix_g IN_F(4)
#define w_in IN_F(5)
#define conv_w IN_F(6)
#define conv_b IN_F(7)
#define w_rg IN_F(8)
#define b_rg IN_F(9)
#define w_ig IN_F(10)
#define b_ig IN_F(11)
#define lru_lambda IN_F(12)
#define fox_b_f IN_F(13)
#define w_out IN_F(14)
#define pre_cross_g IN_F(15)
#define post_cross_g IN_F(16)
#define mem_norm_g IN_F(17)
#define w_cq IN_F(18)
#define w_ck IN_F(19)
#define w_cv IN_F(20)
#define w_co IN_F(21)
#define pre_ffn_g IN_F(22)
#define post_ffn_g IN_F(23)
#define w_gate IN_F(24)
#define w_up IN_F(25)
#define w_down IN_F(26)
#define xres (ap->out)
#define WSP(off) (ap->ws + (off))
#define WGT ((bf16*)WSP(WS_WGT))
#define LRUSP ((float*)WSP(WS_LRUSP))
#define MEMN ((bf16*)WSP(WS_MEMN))
#define LFT ((float*)WSP(WS_LFT))
#define C2 ((float*)WSP(WS_C2))
#define CARA ((float*)WSP(WS_CARA))
#define CARH ((float*)WSP(WS_CARH))
#define CARIN ((float*)WSP(WS_CARIN))
#define KMEM ((bf16*)WSP(WS_KMEM))
#define VTMEM ((bf16*)WSP(WS_VTMEM))
#define WCK ((bf16*)WSP(WS_WCK))
#define WCV ((bf16*)WSP(WS_WCV))
#define XB ((bf16*)WSP(WS_H))
#define RSTD ((float*)WSP(WS_RSTD))
#define MIX ((bf16*)WSP(WS_PT))
#define PK ((bf16*)WSP(WS_BIG))
#define PT ((bf16*)WSP(WS_PT))
#define PBUF ((bf16*)WSP(WS_BIG))
#define WQK ((bf16*)WSP(WS_KWT))
#define VWB ((bf16*)WSP(WS_KWT + 8 * MiB))
#define WCQS ((bf16*)WSP(WS_WCS))
#define WCOS ((bf16*)WSP(WS_WCS + 4 * MiB))
#define HFF ((bf16*)WSP(WS_BIG))
#define ACB ((bf16*)WSP(WS_AU))
#define HLB ((bf16*)WSP(WS_AU + 16 * MiB))
#define RAW ((bf16*)WSP(WS_AU))
#define KWT ((bf16*)WSP(WS_KWT))
#define RVT ((bf16*)WSP(WS_RVT))
#define RKF ((bf16*)WSP(WS_RKF))
#define FVT ((bf16*)WSP(WS_FVT))
#define FKF ((bf16*)WSP(WS_FKF))
#define UT ((float*)WSP(WS_UT))
#define PREV ((bf16*)WSP(WS_PREV))
#define WL(off) ((const bf16*)WSP(WS_W + (size_t)l * W_LAYER + (off)))
extern __shared__ __attribute__((aligned(16))) unsigned char g_lds[];
__device__ __forceinline__ void frame_init(Frame& F) {
    int t = threadIdx.x; asm volatile("" : "+v"(t));
    F.lds = (LAS unsigned char*)g_lds;
    F.MISC = (volatile LAS unsigned*)(F.lds + MISC_OFF);
    F.tid = t; F.lane = t & 63; F.wave = __builtin_amdgcn_readfirstlane(t >> 6);
    F.G = gridDim.x; F.gw = blockIdx.x * NWAVES + F.wave; F.NGW = F.G * NWAVES;
}
#ifndef PROBE_CAT
#define PROBE_CAT (-1)
#endif
#define PROBE_MULT 4u
#define PMISC ((volatile LAS unsigned*)((LAS unsigned char*)g_lds + MISC_OFF))
#define TS(cat) do { if (PROBE_CAT == (cat) && blockIdx.x == 0 && threadIdx.x == 0) PMISC[16] = (unsigned)__builtin_amdgcn_s_memrealtime(); } while (0)
#define TE(cat) do { if (PROBE_CAT == (cat) && blockIdx.x == 0 && threadIdx.x == 0) PMISC[17] += (unsigned)__builtin_amdgcn_s_memrealtime() - PMISC[16]; } while (0)
#define GRID_BAR() xcd_barrier(bar)
#define PH_BEGIN { kargs_t ap = KARGS(); Frame F; frame_init(F);
#define PH_END }
constexpr int CONV_PER_LAYER = 16 * 96 + 16 * 32 + 4 * (4 * 32) + 2 * 16 * 88 + 44 * 32 + 2 * 16 * 32;
constexpr int CONV_R_CO = 16 * 96 + 16 * 32, CONV_R_FFN = CONV_R_CO + 4 * (4 * 32), CONV_R_CK = CONV_R_FFN + 2 * 16 * 88 + 44 * 32;
constexpr int CONV_EARLY0 = CONV_R_CO + (CONV_PER_LAYER - CONV_R_CK), CONV_EARLY1 = CONV_PER_LAYER - CONV_R_CK, CONV_EARLY = CONV_EARLY0 + CONV_EARLY1;
constexpr int CONV_LATE0 = CONV_R_CK - CONV_R_CO, CONV_LATE1 = CONV_R_CK, CONV_LATE = CONV_LATE0 + CONV_LATE1;
static_assert(CONV_EARLY + CONV_LATE == 2 * CONV_PER_LAYER, "conversion item split");
__device__ __forceinline__ void conv_chain(Frame& F, kargs_t ap, LAS float* scr, const int l, const int r) {
    int o = 0;
    unsigned char* wl = WSP(WS_W + (size_t)l * W_LAYER);
    o = conv_matrix(F, scr, o, r, w_in + (size_t)l * D * INW, INW, D, 0, NPROJ, (bf16*)(wl + W_IN), 0, 1, pre_mix_g + l * D);
    o = conv_matrix(F, scr, o, r, w_out + (size_t)l * D * D, D, D, 0, D, (bf16*)(wl + W_OUT), 0, 0, nullptr);
    for (int hc = 0; hc < 4; ++hc)
        o = conv_matrix(F, scr, o, r, w_co + (size_t)l * D * D + (size_t)hc * 256 * D, D, 256, 0, D, WCOS + (size_t)(l * 4 + hc) * 1024 * 256, 0, 0, nullptr);
    o = conv_matrix(F, scr, o, r, w_gate + (size_t)l * D * DFF, DFF, D, 0, DFF, (bf16*)(wl + W_GU), 0, 2, pre_ffn_g + l * D);
    o = conv_matrix(F, scr, o, r, w_up + (size_t)l * D * DFF, DFF, D, 0, DFF, (bf16*)(wl + W_GU), 0, 3, pre_ffn_g + l * D);
    o = conv_matrix(F, scr, o, r, w_down + (size_t)l * DFF * D, D, DFF, 0, D, (bf16*)(wl + W_DN), 0, 0, nullptr);
    o = conv_matrix(F, scr, o, r, w_ck + (size_t)l * D * D, D, D, 0, D, WCK + (size_t)l * D * D, 0, 0, nullptr);
    o = conv_matrix(F, scr, o, r, w_cv + (size_t)l * D * D, D, D, 0, D, WCV + (size_t)l * D * D, 0, 0, nullptr);
}
template <int L> __device__ __forceinline__ void layer_fwd(const XcdBarrier& bar) {
    constexpr int l = L;
    TS(1); TS(8);
        PH_BEGIN
            pg8::Gemm g{XB, WL(W_IN), M, NPROJ, D, 9, 12}; pg8::StaticOrder S; S.init(M, NPROJ, F.G, (int)blockIdx.x);
            pg8::EpiProj E{PK, PKN, PT, PTN, C2FOX, RSTD, FVT, RVT, FKF};
            pg8::gemm_phase<pg8::EpiProj, pg8::StaticOrder, true, true>(F.lds + RING_OFF, g, S, E);
        PH_END
        GRID_BAR();
    TE(1); TE(8);
    TS(2); TS(16);
        PH_BEGIN
        { LAS float* tab = (LAS float*)(F.lds + LRU_TAB_OFF);
          for (int idx = F.tid; idx < 2048; idx += NWAVES * 64) { const int blk = idx >> 9, a = (idx >> 6) & 7, c = 64 * blk + (idx & 63);
              tab[idx] = a < 4 ? conv_w[(size_t)l * 4 * 256 + a * 256 + c] : a == 4 ? conv_b[l * 256 + c] : a == 5 ? b_rg[l * 256 + c] : a == 6 ? b_ig[l * 256 + c] : LRUSP[l * 256 + c]; }
          __syncthreads(); }
        { bf16x8 wgv[2][2][4]; const bf16* wgf = WGT + (size_t)l * 2 * 4 * 64 * 64; const int blk = F.gw & 3;
#pragma unroll
          for (int gt = 0; gt < 2; ++gt)
#pragma unroll
            for (int jt = 0; jt < 2; ++jt)
#pragma unroll
              for (int s_ = 0; s_ < 4; ++s_) wgv[gt][jt][s_] = ld8(wgf + ((size_t)(((gt * 4 + blk) * 2 + jt) * 4 + s_) * 64 + F.lane) * 8);
          for (int u = F.gw; u < 4096; u += F.NGW) lru_block_unit(F, u >> 2, u & 3, PT, wgv, ACB, HLB, CARA, CARH); }
        PH_END
    if (PROBE_CAT == 16) __syncthreads();
    TE(16);
        PH_BEGIN
        if (F.gw < 1024) kchunk_unit(F, F.gw, PT, positions, RKF, RVT, UT);
        else {
            v4u wa[8], wb[8]; int v = F.gw - 1024;
            prep_load(F, v >> 2, v & 3, PK, PT, wa);
#pragma unroll 1
            while (v < 512 * 4) {
                const int vn = v + 1024;
                if (vn < 512 * 4) prep_load(F, vn >> 2, vn & 3, PK, PT, wb);
                prep_unit(F, v >> 2, v & 3, PK, PT, positions, RKF, KWT, RVT, FVT, wa);
#pragma unroll
                for (int i = 0; i < 8; ++i) wa[i] = wb[i];
                v = vn;
            }
        }
        PH_END
        GRID_BAR();
    TE(2);
    TS(3);
        if (L == 0) {
            PH_BEGIN
                const int c = (int)blockIdx.x - 128;
                if (c >= 0 && c < 16) { pg8::Gemm g{MEMN, WCK, BATCH * MEML, 2 * D, D}; pg8::StaticOrder S; S.init(BATCH * MEML, 2 * D, F.G, c);
                    pg8::EpiBlock E{KMEM, 256, 2};
                    pg8::gemm_phase<pg8::EpiBlock, pg8::StaticOrder, true, true>(F.lds + RING_OFF, g, S, E); }
            PH_END
            PH_BEGIN
                const int c = (int)blockIdx.x - 144;
                if (c >= 0 && c < 16) { pg8::Gemm g{MEMN, WCV, BATCH * MEML, 2 * D, D}; pg8::StaticOrder S; S.init(BATCH * MEML, 2 * D, F.G, c);
                    pg8::EpiBlock E{VTMEM, 256, 2};
                    pg8::gemm_phase<pg8::EpiBlock, pg8::StaticOrder, true, true>(F.lds + RING_OFF, g, S, E); }
            PH_END
        }
        PH_BEGIN
        const int x_ = (int)blockIdx.x; const bool busy_ = L == 1 && x_ >= 240;
        const int rs2_ = (L == 1 && x_ >= 32 && x_ < 48) ? 240 + (x_ - 32) : -1;
        const int kn2_ = (L == 1 && x_ >= 48 && x_ < 64) ? 240 + (x_ - 48) : -1;
        v4u kn[16];
        if (!busy_) fox_knorm_load(F, FKF, kn, x_);
        if (blockIdx.x < 32) lru_carry_scan_wg(F, (int)blockIdx.x, CARA, CARH, CARIN);
        if (!busy_) { ret_state_scan_wg(F, UT, PREV, x_);
            __syncthreads(); fox_knorm_reduce(F, kn, (unsigned*)WSP(WS_CTL) + CW_FOXK + 16 * l, x_); }
        if (rs2_ >= 0) { __syncthreads(); ret_state_scan_wg(F, UT, PREV, rs2_); }
        if (kn2_ >= 0) { __syncthreads(); fox_knorm_load(F, FKF, kn, kn2_); fox_knorm_reduce(F, kn, (unsigned*)WSP(WS_CTL) + CW_FOXK + 16 * l, kn2_); }
        PH_END
        if (L == 0 && (blockIdx.x < 128 || (blockIdx.x >= 160 && blockIdx.x < 240))) {
            __syncthreads();
            PH_BEGIN
                LAS float* scr = (LAS float*)(F.lds + RING_OFF + F.wave * 16384);
                const int wl_ = ((int)blockIdx.x < 128 ? (int)blockIdx.x : (int)blockIdx.x - 32) * NWAVES + F.wave;
                for (int f = wl_; f < CONV_LATE; f += 208 * NWAVES) {
                    int l, r;
                    if (f < CONV_LATE0) { l = 0; r = CONV_R_CO + f; } else { l = 1; r = f - CONV_LATE0; }
                    conv_chain(F, ap, scr, l, r);
                }
            PH_END
        }
        if (blockIdx.x >= 240) { __syncthreads(); PH_BEGIN cscan_job(F, LFT, C2, (int)blockIdx.x - 240); PH_END }
        PH_BEGIN
        PH_END
        GRID_BAR();
    TE(3);
    TS(4);
        PH_BEGIN
        PH_END
        PH_BEGIN
            const int x = (int)blockIdx.x;
            if (F.G == 256) {
                { volatile LAS int* inv = (volatile LAS int*)(F.lds + LRU_TAB_OFF + 4160);
                  if (F.tid < 16) { const float mine = C2[(size_t)F.tid * SEQ + SEQ - 1]; int rk = 0;
                      for (int o_ = 0; o_ < 16; ++o_) { const float oth = C2[(size_t)o_ * SEQ + SEQ - 1]; rk += (oth < mine || (oth == mine && o_ < F.tid)) ? 1 : 0; }
                      inv[rk] = F.tid; }
                  __syncthreads(); }
#pragma unroll 1
                for (int i = 0; i < 4; ++i) { const int j_ = x & 15, rk_ = i == 0 ? j_ : i == 1 ? 15 - j_ : i == 2 ? ((j_ + 8) & 15) : 15 - ((j_ + 8) & 15);
                    const int bh = ((volatile LAS int*)(F.lds + LRU_TAB_OFF + 4160))[rk_], qb = (x >> 4) + 16 * i;
                    const int T_lo = 8 * qb - 8 > 0 ? 8 * qb - 8 : 0, nst = 8 * qb + 8 - T_lo;
                    __syncthreads();
                    fox_stage(F, FKF + (size_t)bh * 512 * 4 * 512, FVT + (size_t)bh * 512 * 4 * 512, C2 + (size_t)bh * SEQ, T_lo, nst, nst - 8, nst, true);
                    const bf16* nxk = nullptr; const bf16* nxv = nullptr;
                    if (i < 3) { const int rn_ = i == 0 ? 15 - j_ : i == 1 ? ((j_ + 8) & 15) : 15 - ((j_ + 8) & 15); const int bhn = ((volatile LAS int*)(F.lds + LRU_TAB_OFF + 4160))[rn_], qbn = (x >> 4) + 16 * (i + 1);
                        const int Tn = 8 * qbn - 8;
                        nxk = FKF + ((size_t)bhn * 512 * 4 + (size_t)Tn * 4) * 512; nxv = FVT + ((size_t)bhn * 512 * 4 + (size_t)Tn * 4) * 512; }
                    fox_unit(F, bh >> 3, bh & 7, 8 * qb + F.wave, PK, FKF, FVT, C2, MIX, (const unsigned*)WSP(WS_CTL) + CW_FOXK + 16 * l, T_lo, nst, nxk, nxv); }
                __syncthreads();
            }
        PH_END
        PH_BEGIN
        lru_final(F, ACB, HLB, CARIN, PK, MIX);
#pragma unroll 1
        for (int i = 0; i < 2; ++i) { const int u0 = F.gw + i * F.NGW; if (u0 < 4096) { const int u = i == 0 ? u0 : ((((u0 >> 2)) ^ 3) << 2) | (u0 & 3); ret_final_unit(F, u, PK, RKF, RVT, PREV, MIX); } }
        PH_END
        GRID_BAR();
    TE(4);
    TS(1); TS(9);
        PH_BEGIN
            pg8::Gemm g{MIX, WL(W_OUT), M, D, D}; pg8::StaticOrder S; S.init(M, D, F.G, (int)blockIdx.x);
            pg8::EpiPlain E{RAW, D, 1.f, 0, 0, nullptr, nullptr, 0, 1 << 30};
            pg8::gemm_phase<pg8::EpiPlain, pg8::StaticOrder, true, true>(F.lds + RING_OFF, g, S, E);
        PH_END
        GRID_BAR();
    TE(1); TE(9);
    TS(7);
        if (L == 0) {
            PH_BEGIN
                pg8::Gemm g{KMEM, WCQS, 16 * 256, 8 * 1024, 256}; pg8::PairOrder S{(int)blockIdx.x, false};
                pg8::EpiBlock E{WQK, 1024, 0};
                pg8::gemm_phase<pg8::EpiBlock, pg8::PairOrder, true, true>(F.lds + RING_OFF, g, S, E);
            PH_END
            PH_BEGIN
                pg8::Gemm g{WCOS, VTMEM, 8 * 1024, 16 * 256, 256}; pg8::PairOrder S{(int)blockIdx.x - 64, true};
                pg8::EpiBlock E{VWB, 1024, 1};
                pg8::gemm_phase<pg8::EpiBlock, pg8::PairOrder, true, true>(F.lds + RING_OFF, g, S, E);
            PH_END
        }
        if (L == 0) {
            PH_BEGIN
            if (blockIdx.x < 128) thin4<1>(F, RAW, XB, XB, nullptr, post_mix_g + l * D, RSTD, 0, 12288, F.gw, 1024);
            else thin4<1>(F, RAW, XB, XB, nullptr, post_mix_g + l * D, RSTD, 12288, M, F.gw - 1024, 1024);
            PH_END
        } else {
            PH_BEGIN
            thin_pass<1, false>(F, RAW, nullptr, XB, nullptr, post_mix_g + l * D, RSTD, nullptr, nullptr, nullptr, nullptr);
            PH_END
        }
        GRID_BAR();
    TE(7);
    TS(1); TS(10);
        PH_BEGIN
            pg8::Gemm g{XB, WQK + (size_t)l * 2 * 1024 * 1024, M, D, D, 0, 0, (size_t)1024 * 1024 * 2, 6}; pg8::StaticOrder S; S.init(M, D, F.G, (int)blockIdx.x);
            pg8::EpiSoftmax E{PBUF, RSTD, (LAS float*)(F.lds + LRU_TAB_OFF)};
            pg8::gemm_phase<pg8::EpiSoftmax, pg8::StaticOrder, true, true>(F.lds + RING_OFF, g, S, E);
        PH_END
        GRID_BAR();
    TE(1); TE(10);
    TS(1); TS(11);
        PH_BEGIN
            pg8::Gemm g{PBUF, VWB + (size_t)l * 2 * 1024 * 1024, M, D, D, 0, 0, (size_t)1024 * 1024 * 2, 6}; pg8::StaticOrder S; S.init(M, D, F.G, (int)blockIdx.x);
            pg8::EpiPlain E{RAW, D, 1.f, 0, 0, nullptr, nullptr, 0, 1 << 30};
            pg8::gemm_phase<pg8::EpiPlain, pg8::StaticOrder, true, true>(F.lds + RING_OFF, g, S, E);
        PH_END
        GRID_BAR();
    TE(1); TE(11);
    TS(7);
        PH_BEGIN
        thin_pass<1, false>(F, RAW, nullptr, XB, nullptr, post_cross_g + l * D, RSTD, nullptr, nullptr, nullptr, nullptr);
        PH_END
        GRID_BAR();
    TE(7);
    TS(1); TS(12);
        PH_BEGIN
            pg8::Gemm g{XB, WL(W_GU), M, 2 * DFF, D}; pg8::StaticOrder S; S.init(M, 2 * DFF, F.G, (int)blockIdx.x);
            pg8::EpiSwiGLU E{HFF, DFF, RSTD};
            pg8::gemm_phase<pg8::EpiSwiGLU, pg8::StaticOrder, true, true>(F.lds + RING_OFF, g, S, E);
        PH_END
        GRID_BAR();
    TE(1); TE(12);
    TS(1); TS(13);
        PH_BEGIN
            pg8::Gemm g{HFF, WL(W_DN), M, D, DFF}; pg8::StaticOrder S; S.init(M, D, F.G, (int)blockIdx.x);
            pg8::EpiPlain E{RAW, D, 1.f, 0, 0, nullptr, nullptr, 0, 1 << 30};
            pg8::gemm_phase<pg8::EpiPlain, pg8::StaticOrder, true, true>(F.lds + RING_OFF, g, S, E);
        PH_END
        GRID_BAR();
    TE(1); TE(13);
    TS(7);
        if (l == 0) { PH_BEGIN thin_pass<1, true>(F, RAW, nullptr, XB, nullptr, post_ffn_g + l * D, RSTD, pre_mix_g + (l + 1) * D, w_in + (size_t)(l + 1) * D * INW, fox_b_f + (l + 1) * 8, LFT); PH_END GRID_BAR(); }
        else { PH_BEGIN thin_pass<2, false>(F, RAW, nullptr, XB, xres, post_ffn_g + l * D, nullptr, nullptr, nullptr, nullptr, nullptr); PH_END }
    TE(7);
}

__global__ void __launch_bounds__(NWAVES * 64, 2) hymba_fwd(Args args) {
    for (int u = threadIdx.x; u < (LDS_BYTES - LDSCTL_OFF) / 4; u += NWAVES * 64) ((LAS unsigned*)((LAS unsigned char*)g_lds + LDSCTL_OFF))[u] = 0u;
    __syncthreads();
    XcdBarrier bar = xcd_barrier_post((unsigned*)(args.ws + WS_CTL) + CW_BAR, (volatile LAS unsigned*)((LAS unsigned char*)g_lds + MISC_OFF) + 8);
    TS(0);
    PH_BEGIN
        LAS float* scr = (LAS float*)(F.lds + RING_OFF + F.wave * 16384);
        for (int e = F.gw; e < CONV_EARLY; e += F.NGW) {
            int l, r;
            if (e < CONV_EARLY0) { l = 0; r = e < CONV_R_CO ? e : e - CONV_R_CO + CONV_R_CK; } else { l = 1; r = CONV_R_CK + (e - CONV_EARLY0); }
            conv_chain(F, ap, scr, l, r);
        }
        for (int it = blockIdx.x * (NWAVES * 64) + F.tid; it < 2 * 4 * 1024 * 32; it += F.G * NWAVES * 64) {
            const int d8 = it & 31, hin = (it >> 5) & 1023, hc = (it >> 15) & 3, l = it >> 17;
            const float* src = w_cq + (size_t)l * D * D + (size_t)hin * D + 256 * hc + 8 * d8; const f32x4 a = *(const f32x4*)src, b = *(const f32x4*)(src + 4);
            const float g = pre_cross_g[l * D + hin] * C2CROSS;
            v4u o; o.x = pk2(a[0] * g, a[1] * g); o.y = pk2(a[2] * g, a[3] * g); o.z = pk2(b[0] * g, b[1] * g); o.w = pk2(b[2] * g, b[3] * g);
            *(v4u*)(WCQS + ((size_t)((l * 4 + hc) * 1024 + hin)) * 256 + 8 * d8) = o;
        }
        for (int e = blockIdx.x * (NWAVES * 64) + F.tid; e < 2 * 2 * 4 * 64 * 64; e += F.G * NWAVES * 64) {
            const int q = e & 7, ln = (e >> 3) & 63, s_ = (e >> 9) & 3, jt = (e >> 11) & 1, blk = (e >> 12) & 3, gate = (e >> 14) & 1, l = e >> 15;
            const int i = 16 * s_ + 8 * (ln >> 5) + q, j = 32 * jt + (ln & 31);
            const float* src = gate ? w_ig : w_rg; WGT[e] = (bf16)(pk2(src[(((size_t)l * 4 + blk) * 64 + i) * 64 + j], 0.f) & 0xffffu);
        }
        if (blockIdx.x == 0) { const int e = F.tid; const float lam = lru_lambda[e]; LRUSP[e] = 8.0f * log1pf(expf(-lam)); }
        for (int row = F.gw; row < BATCH * MEML; row += F.NGW) {
            f32x4 v[4]; float ss = 0.f;
#pragma unroll
            for (int j = 0; j < 4; ++j) { v[j] = *(const f32x4*)(mem + (size_t)row * D + 4 * F.lane + 256 * j); ss += (v[j][0] * v[j][0] + v[j][1] * v[j][1]) + (v[j][2] * v[j][2] + v[j][3] * v[j][3]); }
            const float rstd = 1.0f / sqrtf(wave_sum(ss) * (1.0f / D) + EPS);
#pragma unroll
            for (int j = 0; j < 4; ++j) { const f32x4 g = *(const f32x4*)(mem_norm_g + 4 * F.lane + 256 * j); v2u w; w.x = pk2(v[j][0] * rstd * g[0], v[j][1] * rstd * g[1]); w.y = pk2(v[j][2] * rstd * g[2], v[j][3] * rstd * g[3]);
                *(v2u*)(MEMN + (size_t)row * D + 4 * F.lane + 256 * j) = w; }
        }
        __syncthreads();
    PH_END
    PH_BEGIN
        thin_pass<0, true>(F, nullptr, x_in, XB, nullptr, nullptr, RSTD, pre_mix_g, w_in, fox_b_f, LFT);
    PH_END
    GRID_BAR();
    TE(0);
    layer_fwd<0>(bar);
    layer_fwd<1>(bar);
    if (PROBE_CAT >= 0 && blockIdx.x == 0 && threadIdx.x == 0) {
        const unsigned acc = PMISC[17]; const unsigned long long t0 = __builtin_amdgcn_s_memrealtime();
        while ((unsigned)(__builtin_amdgcn_s_memrealtime() - t0) < PROBE_MULT * acc) __builtin_amdgcn_s_sleep(20);
    }
}

extern "C" void kernel_launch(void* const* d_in, const int* in_sizes, int n_in, void* d_out, int out_size, void* d_ws, size_t ws_size, hipStream_t stream) {
    static int grid = 0;
    if (grid == 0) {
        if (n_in != 27 || in_sizes[0] != M * D || out_size != M * D || ws_size < WS_END) { fprintf(stderr, "kernel_launch: unexpected shapes / workspace (n_in %d, ws %zu, need %zu); nothing launched\n", n_in, ws_size, (size_t)WS_END); grid = -1; return; }
        int dev = 0, cus = 0;
        if (hipGetDevice(&dev) != hipSuccess || hipDeviceGetAttribute(&cus, hipDeviceAttributeMultiprocessorCount, dev) != hipSuccess) { grid = -1; return; }
        if (hipFuncSetAttribute((const void*)hymba_fwd, hipFuncAttributeMaxDynamicSharedMemorySize, LDS_BYTES) != hipSuccess) { fprintf(stderr, "kernel_launch: hipFuncSetAttribute failed\n"); grid = -1; return; }
        (void)hipGetLastError();
        if (cus < 256) { fprintf(stderr, "kernel_launch: needs 256 CUs\n"); grid = -1; return; }
        grid = 256;
    }
    if (grid < 0) return;
    if (hipMemsetAsync((char*)d_ws + WS_CTL, 0, CTL_ZERO_BYTES, stream) != hipSuccess) return;
    Args a{};
    for (int i = 0; i < 27; ++i) a.in[i] = (const float*)d_in[i];
    a.out = (float*)d_out; a.ws = (unsigned char*)d_ws;
    hipLaunchKernelGGL(hymba_fwd, dim3(grid), dim3(NWAVES * 64), LDS_BYTES, stream, a);
}
```
